# Optimizing an MI355X kernel written in HIP

```python
import math
import jax, jax.numpy as jnp
from jax import lax
import numpy as np

D_MODEL = 2048
BATCH = 4
SEQ = 2048
DEPTH = 1

CHUNK = 64
PLE_DIM = 256
D_MIX = D_MODEL
RET_WIDTH = D_MIX // 2
DIFF_WIDTH = D_MIX - RET_WIDTH
RET_HEADS = 8
RET_DV = RET_WIDTH // RET_HEADS
RET_DK = RET_DV // 2
DIFF_HEADS = 8
DIFF_DV = DIFF_WIDTH // DIFF_HEADS
DIFF_DH = DIFF_DV // 2
Q_BLOCK = 128
ROPE_BASE = 10000.0
EPS = 1e-6
RET_Q_COLS = RET_HEADS * RET_DK
RET_K_COLS = RET_HEADS * RET_DK
RET_V_COLS = RET_WIDTH
RET_G_COLS = RET_WIDTH
DIFF_Q_COLS = DIFF_HEADS * 2 * DIFF_DH
DIFF_K_COLS = DIFF_HEADS * 2 * DIFF_DH
DIFF_V_COLS = DIFF_WIDTH
DIFF_G_COLS = DIFF_WIDTH
D_IN = RET_Q_COLS + RET_K_COLS + RET_V_COLS + RET_G_COLS + DIFF_Q_COLS + DIFF_K_COLS + DIFF_V_COLS + DIFF_G_COLS

kernel_name = 'hybrid_retention_diffattn_layer'

F32 = jnp.float32


def rmsnorm(t, g):
    tf = t.astype(F32)
    out = tf * lax.rsqrt(jnp.mean(tf * tf, axis=-1, keepdims=True) + EPS) * g.astype(F32)
    return out.astype(t.dtype)


def rope(t, cos, sin):
    half = t.shape[-1] // 2
    t1, t2 = t[..., :half], t[..., half:]
    c = cos[None, :, None, :]
    s = sin[None, :, None, :]
    return jnp.concatenate([t1 * c - t2 * s, t1 * s + t2 * c], axis=-1)


def retention(q, k, v):
    b, s = q.shape[:2]
    n = s // CHUNK
    log_g = jnp.log1p(-jnp.exp2(-5.0 - jnp.arange(RET_HEADS, dtype=F32)))
    idx = jnp.arange(CHUNK, dtype=F32)
    d_intra = jnp.exp(jnp.abs(idx[:, None] - idx[None, :])[None] * log_g[:, None, None])
    xi = jnp.exp((idx + 1.0)[None, :] * log_g[:, None])
    zeta = jnp.exp((CHUNK - 1.0 - idx)[None, :] * log_g[:, None])
    g_chunk = jnp.exp(CHUNK * log_g)
    qc = q.astype(F32).reshape(b, n, CHUNK, RET_HEADS, RET_DK)
    kc = k.astype(F32).reshape(b, n, CHUNK, RET_HEADS, RET_DK)
    vc = v.astype(F32).reshape(b, n, CHUNK, RET_HEADS, RET_DV)
    scores = jnp.einsum('bnihd,bnjhd->bnhij', qc, kc) * d_intra
    intra = jnp.einsum('bnhij,bnjhe->bnihe', scores, vc)
    kv = jnp.einsum('bnjhd,bnjhe,hj->nbhde', kc, vc, zeta)

    def step(state, kv_n):
        return state * g_chunk[None, :, None, None] + kv_n, state

    _, r_prev = lax.scan(step, jnp.zeros((b, RET_HEADS, RET_DK, RET_DV), F32), kv)
    cross = jnp.einsum('bnihd,nbhde->bnihe', qc, r_prev) * xi.T[None, None, :, :, None]
    return (intra + cross).reshape(b, s, RET_HEADS, RET_DV)


def diff_attention(q, k, v, lam):
    b, s = q.shape[:2]
    nb = s // Q_BLOCK
    scale = DIFF_DH ** -0.5
    key_chunk = jnp.arange(s) // CHUNK
    kf = k.astype(F32)
    vf = v.astype(F32)
    qb = (q.astype(F32) * scale).reshape(b, nb, Q_BLOCK, DIFF_HEADS, 2, DIFF_DH).transpose(1, 0, 2, 3, 4, 5)

    def block(args):
        q_blk, blk = args
        q_chunk = (blk * Q_BLOCK + jnp.arange(Q_BLOCK)) // CHUNK
        mask = key_chunk[None, :] <= q_chunk[:, None]
        sc = jnp.einsum('bqhcd,bkhcd->bhcqk', q_blk, kf)
        sc = jnp.where(mask, sc, -jnp.inf)
        pr = jax.nn.softmax(sc, axis=-1)
        attn = pr[:, :, 0] - lam * pr[:, :, 1]
        return jnp.einsum('bhqk,bkhe->bqhe', attn, vf)

    out = lax.map(block, (qb, jnp.arange(nb)))
    return out.transpose(1, 0, 2, 3, 4).reshape(b, s, DIFF_HEADS, DIFF_DV)


def setup_inputs(seed: int = 0) -> dict:
    key = jax.random.key(seed)
    ks = jax.random.split(key, 20)
    nrm = lambda k_, shape: jax.random.normal(k_, shape, F32)
    return {
        'x': nrm(ks[0], (BATCH, SEQ, D_MODEL)),
        'p': nrm(ks[1], (DEPTH, BATCH, SEQ, PLE_DIM)),
        'attn_norm': 1.0 + 0.01 * nrm(ks[2], (DEPTH, D_MODEL)),
        'w_in': nrm(ks[3], (DEPTH, D_MODEL, D_IN)) * D_MODEL ** -0.5,
        'ret_gn': 1.0 + 0.01 * nrm(ks[4], (DEPTH, RET_WIDTH)),
        'diff_qn': 1.0 + 0.01 * nrm(ks[5], (DEPTH, DIFF_DH)),
        'diff_kn': 1.0 + 0.01 * nrm(ks[6], (DEPTH, DIFF_DH)),
        'diff_lq1': 0.1 * nrm(ks[7], (DEPTH, DIFF_DH)),
        'diff_lk1': 0.1 * nrm(ks[8], (DEPTH, DIFF_DH)),
        'diff_lq2': 0.1 * nrm(ks[9], (DEPTH, DIFF_DH)),
        'diff_lk2': 0.1 * nrm(ks[10], (DEPTH, DIFF_DH)),
        'diff_subln': 1.0 + 0.01 * nrm(ks[11], (DEPTH, DIFF_DV)),
        'w_out': nrm(ks[12], (DEPTH, D_MIX, D_MODEL)) * D_MIX ** -0.5,
        'ple_norm': 1.0 + 0.01 * nrm(ks[13], (DEPTH, D_MODEL)),
        'w_ple_gate': nrm(ks[14], (DEPTH, D_MODEL, D_MODEL)) * D_MODEL ** -0.5,
        'w_ple_proj': nrm(ks[15], (DEPTH, PLE_DIM, D_MODEL)) * PLE_DIM ** -0.5,
    }


def reference(x, p, attn_norm, w_in, ret_gn, diff_qn, diff_kn, diff_lq1, diff_lk1, diff_lq2, diff_lk2, diff_subln, w_out, ple_norm, w_ple_gate, w_ple_proj):
    b, s, _ = x.shape
    pos = jnp.arange(s, dtype=F32)
    inv_freq = ROPE_BASE ** (-jnp.arange(RET_DK // 2, dtype=F32) / (RET_DK // 2))
    ang = pos[:, None] * inv_freq[None, :]
    cos, sin = jnp.cos(ang), jnp.sin(ang)
    o1 = RET_Q_COLS
    o2 = o1 + RET_K_COLS
    o3 = o2 + RET_V_COLS
    o4 = o3 + RET_G_COLS
    o5 = o4 + DIFF_Q_COLS
    o6 = o5 + DIFF_K_COLS
    o7 = o6 + DIFF_V_COLS
    h = x
    for i in range(DEPTH):
        u = rmsnorm(h, attn_norm[i])
        z = u @ w_in[i]
        rq, rk, rv, rg, dq, dk, dv, dg = jnp.split(z, [o1, o2, o3, o4, o5, o6, o7], axis=-1)
        rq = rope(rq.reshape(b, s, RET_HEADS, RET_DK).astype(F32), cos, sin)
        rk = rope(rk.reshape(b, s, RET_HEADS, RET_DK).astype(F32), cos, sin) * RET_DK ** -0.5
        ro = retention(rq, rk, rv.reshape(b, s, RET_HEADS, RET_DV))
        ro = rmsnorm(ro, ret_gn[i].reshape(RET_HEADS, RET_DV)).reshape(b, s, RET_WIDTH)
        ro = ro * jax.nn.silu(rg.astype(F32))
        lam_init = 0.8 - 0.6 * math.exp(-0.3 * i)
        lam = (jnp.exp(jnp.sum(diff_lq1[i].astype(F32) * diff_lk1[i].astype(F32)))
               - jnp.exp(jnp.sum(diff_lq2[i].astype(F32) * diff_lk2[i].astype(F32))) + lam_init)
        dq = rmsnorm(dq.reshape(b, s, DIFF_HEADS, 2, DIFF_DH), diff_qn[i])
        dk = rmsnorm(dk.reshape(b, s, DIFF_HEADS, 2, DIFF_DH), diff_kn[i])
        do = diff_attention(dq, dk, dv.reshape(b, s, DIFF_HEADS, DIFF_DV), lam)
        do = rmsnorm(do, diff_subln[i]) * (1.0 - lam_init)
        do = do.reshape(b, s, DIFF_WIDTH) * jax.nn.silu(dg.astype(F32))
        mixed = jnp.concatenate([ro, do], axis=-1).astype(h.dtype)
        h = h + mixed @ w_out[i]
        gate = jax.nn.sigmoid(rmsnorm(h, ple_norm[i]) @ w_ple_gate[i])
        h = h + gate * (p[i] @ w_ple_proj[i])
    return h
```

```cpp
#include <hip/hip_runtime.h>
#include <cstdio>
#include <cstdint>

#define LAS __attribute__((address_space(3)))
#define GAS __attribute__((address_space(1)))
typedef unsigned short bf16_t;
typedef short bf16x8 __attribute__((ext_vector_type(8)));
typedef short s16x4 __attribute__((ext_vector_type(4)));
typedef float f32x4 __attribute__((ext_vector_type(4)));
typedef float f32x2 __attribute__((ext_vector_type(2)));
typedef __bf16 bf16x2_t __attribute__((ext_vector_type(2)));
typedef unsigned u32x4 __attribute__((ext_vector_type(4)));
typedef unsigned u32x2 __attribute__((ext_vector_type(2)));

constexpr int M = 8192, DM = 2048, DIN = 7168, PLE = 256, SEQ = 2048;
constexpr float EPS = 1e-6f;
constexpr int NWAVES = 8;
constexpr int LDS_BYTES = 147456;
constexpr size_t MiB = 1u << 20;
constexpr size_t WS_ROWSS = 0;
constexpr size_t WS_BAR = 65536;
constexpr size_t WS_PTRS = 131072;
constexpr size_t WS_TAB = 1 * MiB;
constexpr size_t WS_WIN = 2 * MiB;
constexpr size_t WS_WOUT = 30 * MiB;
constexpr size_t WS_WG = 38 * MiB;
constexpr size_t WS_WP = 46 * MiB;
constexpr size_t WS_U = 47 * MiB;
constexpr size_t WS_MIX = WS_U;
constexpr size_t WS_PB = 79 * MiB;
constexpr size_t WS_Z = 83 * MiB;
constexpr size_t WS_HB = WS_Z;
constexpr size_t WS_PP = 195 * MiB;
constexpr size_t WS_END = 227 * MiB;

__device__ __forceinline__ unsigned cvtpk(float lo, float hi) { f32x2 v = {lo, hi}; bf16x2_t b = __builtin_convertvector(v, bf16x2_t); return __builtin_bit_cast(unsigned, b); }
__device__ __forceinline__ float bflo(unsigned u) { return __uint_as_float(u << 16); }
__device__ __forceinline__ float bfhi(unsigned u) { return __uint_as_float(u & 0xffff0000u); }
__device__ __forceinline__ int lane_id() { return (int)__builtin_amdgcn_mbcnt_hi(~0u, __builtin_amdgcn_mbcnt_lo(~0u, 0u)); }
__device__ __forceinline__ float quad_sum(float v) {
    v += __uint_as_float((unsigned)__builtin_amdgcn_ds_swizzle((int)__float_as_uint(v), 0x401F));
    const auto rr = __builtin_amdgcn_permlane32_swap(__float_as_uint(v), __float_as_uint(v), false, false);
    return __uint_as_float(rr[0]) + __uint_as_float(rr[1]);
}
__device__ __forceinline__ float wave_sum(float v) {
#pragma unroll
    for (int o = 1; o < 64; o <<= 1) v += __shfl_xor(v, o);
    return v;
}
__device__ __forceinline__ float wave_max(float v) {
#pragma unroll
    for (int o = 1; o < 64; o <<= 1) v = fmaxf(v, __shfl_xor(v, o));
    return v;
}

__device__ __forceinline__ float lg2gamma(int h) {
    return h == 0 ? -0.04580368961312479f : h == 1 ? -0.02272007650008353f : h == 2 ? -0.011315313227834146f : h == 3 ? -0.005646563141142063f :
           h == 4 ? -0.0028205190623786626f : h == 5 ? -0.0014095702546713536f : h == 6 ? -0.0007046129765893727f : -0.0003522634716290214f;
}

namespace pg8 {
constexpr int BM = 256, BK = 64, HALF = 128, HTB = HALF * BK * 2, STAGE_BYTES = 8 * HTB, NXCD = 8, WGM = 8;
__host__ __device__ __forceinline__ int lds_byte(int r, int c) { const int st = (r >> 4) * 2 + (c >> 5), rr = r & 15, cc = c & 31, ob = rr * 64 + cc * 2; return st * 1024 + (ob ^ (((ob >> 9) & 1) << 5)); }
__host__ __device__ __forceinline__ void stage_rc(int b, int& R, int& C) { const int st = b / 1024, sb = b % 1024, swz = sb ^ (((sb >> 9) & 1) << 5); R = (st >> 1) * 16 + swz / 64; C = (st & 1) * 32 + (swz % 64) / 2; }
__host__ __device__ __forceinline__ int perm32(int rho) { const int n = rho >> 4, i = rho & 15; return 8 * (i >> 2) + 4 * n + (i & 3); }

struct Unit { int pm, pn; };
struct Gemm { const bf16_t* A; const bf16_t* Bt; int M, N, K; };

struct StaticOrder {
    int nM, nN, nwg, G, c;
    __device__ void init(int M_, int N_, int G_, int c_) { nM = M_ / BM; nN = N_ / BM; nwg = nM * nN; G = G_; c = c_; }
    __device__ bool next(int i, Unit& u) const {
        const long L = (long)i * G + c; if (c < 0 || L >= nwg) return false;
        int wgid = (int)L; { const int q = nwg / NXCD, r = nwg % NXCD, xcd = wgid % NXCD, off = wgid / NXCD; wgid = (xcd < r ? xcd * (q + 1) : r * (q + 1) + (xcd - r) * q) + off; }
        const int nig = WGM * nN, gid = wgid / nig, fm = gid * WGM, gsz = (nM - fm) < WGM ? (nM - fm) : WGM;
        u.pm = fm + ((wgid % nig) % gsz); u.pn = (wgid % nig) / gsz; return true;
    }
};

template <class Epi, bool ALIGN_EPI>
__device__ __forceinline__ void gemm_phase(LAS unsigned char* lds, const Gemm g, const StaticOrder& S, const Epi& E, const int wid) {
    int lane = lane_id(); asm volatile("" : "+v"(lane));
    const int tid = wid * 64 + lane, wr = wid >> 2, wc = wid & 3, fr = lane & 15, fq = lane >> 4;
    const int K = g.K, nt = K / BK;
    unsigned voffA[2], voffB[2];
#pragma unroll
    for (int i = 0; i < 2; ++i) { int R, C; stage_rc(tid * 16 + i * 8192, R, C); const int Rb = 64 * (R >> 5) + perm32(R & 31);
        voffA[i] = (unsigned)(R * K + C) * 2u; voffB[i] = (unsigned)(Rb * K + C) * 2u; }
    const size_t kstep = (size_t)(BK * 2);
    const size_t hstep = (size_t)HALF * K * 2;
    const size_t hstepB = (size_t)32 * K * 2;
    const size_t tstep = 2 * hstep;
    const unsigned ldsw = (unsigned)wid * 1024u;
    const int aoff = lds_byte(wr * 64 + fr, fq * 8), boff = lds_byte(wc * 32 + fr, fq * 8);
#define PG8_SA(b, h) (((b) * 2 + (h)) * HTB)
#define PG8_SB(b, h) ((4 + (b) * 2 + (h)) * HTB)
#define PG8_STAGE(bufoff, gbase, voff) do { unsigned long long _gb = (unsigned long long)(gbase); asm volatile("" : "+s"(_gb)); _Pragma("unroll") for (int _i = 0; _i < 2; ++_i) \
        __builtin_amdgcn_global_load_lds((const GAS unsigned*)((const GAS char*)_gb + (voff)[_i]), (LAS unsigned*)(lds + (bufoff) + ldsw + _i * 8192), 16, 0, 0); } while (0)
#define PG8_LDA(dst, b, h) do { _Pragma("unroll") for (int m = 0; m < 4; ++m) _Pragma("unroll") for (int k = 0; k < 2; ++k) dst[m][k] = *(const LAS bf16x8*)(lds + PG8_SA(b, h) + aoff + m * 2048 + k * 1024); } while (0)
#define PG8_LDB(dst, b, h) do { _Pragma("unroll") for (int n = 0; n < 2; ++n) _Pragma("unroll") for (int k = 0; k < 2; ++k) dst[n][k] = *(const LAS bf16x8*)(lds + PG8_SB(b, h) + boff + n * 2048 + k * 1024); } while (0)
#define PG8_MMA(ai, bj, At, Bt) do { __builtin_amdgcn_s_setprio(1); _Pragma("unroll") for (int m = 0; m < 4; ++m) _Pragma("unroll") for (int n = 0; n < 2; ++n) _Pragma("unroll") for (int k = 0; k < 2; ++k) \
        acc[ai][bj][m][n] = __builtin_amdgcn_mfma_f32_16x16x32_bf16(Bt[n][k], At[m][k], acc[ai][bj][m][n], 0, 0, 0); __builtin_amdgcn_s_setprio(0); } while (0)
#define PG8_WAIT_V(n) asm volatile("s_waitcnt vmcnt(" #n ")" ::: "memory")
#define PG8_WAIT_L(n) asm volatile("s_waitcnt lgkmcnt(" #n ")" ::: "memory")
#define PG8_BAR __builtin_amdgcn_s_barrier()
#define PG8_SCHED __builtin_amdgcn_sched_barrier(0)
    Unit cur, nxt; int ui = 0;
    if (!S.next(0, cur)) return;
    f32x4 acc[2][2][4][2];
#pragma unroll
    for (int a = 0; a < 2; ++a)
#pragma unroll
        for (int b = 0; b < 2; ++b)
#pragma unroll
            for (int m = 0; m < 4; ++m)
#pragma unroll
                for (int n = 0; n < 2; ++n) acc[a][b][m][n] = (f32x4){0.f, 0.f, 0.f, 0.f};
    bf16x8 At[4][2], B0[2][2], B1[2][2];
    const char* cA = (const char*)g.A + (size_t)cur.pm * tstep; const char* cB = (const char*)g.Bt + (size_t)cur.pn * tstep;
    PG8_STAGE(PG8_SB(0, 0), cB, voffB); PG8_STAGE(PG8_SB(0, 1), cB + hstepB, voffB); PG8_STAGE(PG8_SA(0, 0), cA, voffA); PG8_STAGE(PG8_SA(0, 1), cA + hstep, voffA);
    if (wr == 1) PG8_BAR;
    PG8_WAIT_V(2); PG8_BAR;
    PG8_STAGE(PG8_SB(1, 0), cB + kstep, voffB); PG8_STAGE(PG8_SA(1, 0), cA + kstep, voffA); PG8_STAGE(PG8_SB(1, 1), cB + hstepB + kstep, voffB);
    PG8_WAIT_V(6); PG8_BAR;
    for (;;) {
        const bool has_next = S.next(ui + 1, nxt);
        const char* nA = has_next ? (const char*)g.A + (size_t)nxt.pm * tstep : cA; const char* nB = has_next ? (const char*)g.Bt + (size_t)nxt.pn * tstep : cB;
        for (int t = 0; t < nt; t += 2) {
            const bool last = (t == nt - 2);
            const char* a1 = cA + (size_t)(t + 1) * kstep;
            const char* a2 = last ? nA : cA + (size_t)(t + 2) * kstep; const char* b2 = last ? nB : cB + (size_t)(t + 2) * kstep;
            const char* a3 = a2 + kstep; const char* b3 = b2 + kstep;
            PG8_LDB(B0, 0, 0); PG8_LDB(B1, 0, 1); PG8_SCHED; PG8_LDA(At, 0, 0); PG8_STAGE(PG8_SA(1, 1), a1 + hstep, voffA);
            PG8_WAIT_V(8); PG8_WAIT_L(0); PG8_BAR; PG8_MMA(0, 0, At, B0); PG8_MMA(0, 1, At, B1); PG8_BAR; PG8_SCHED;
            PG8_LDA(At, 0, 1); PG8_STAGE(PG8_SB(0, 0), b2, voffB); PG8_STAGE(PG8_SB(0, 1), b2 + hstepB, voffB); PG8_STAGE(PG8_SA(0, 0), a2, voffA);
            PG8_WAIT_V(8); PG8_WAIT_L(0); PG8_BAR; PG8_MMA(1, 0, At, B0); PG8_MMA(1, 1, At, B1); PG8_BAR; PG8_SCHED;
            PG8_LDB(B0, 1, 0); PG8_LDB(B1, 1, 1); PG8_SCHED; PG8_LDA(At, 1, 0); PG8_STAGE(PG8_SA(0, 1), a2 + hstep, voffA);
            PG8_WAIT_V(8); PG8_WAIT_L(0); PG8_BAR; PG8_MMA(0, 0, At, B0); PG8_MMA(0, 1, At, B1); PG8_BAR; PG8_SCHED;
            PG8_LDA(At, 1, 1); PG8_STAGE(PG8_SB(1, 0), b3, voffB); PG8_STAGE(PG8_SB(1, 1), b3 + hstepB, voffB); PG8_STAGE(PG8_SA(1, 0), a3, voffA);
            PG8_WAIT_V(8); PG8_WAIT_L(0); PG8_BAR; PG8_MMA(1, 0, At, B0); PG8_MMA(1, 1, At, B1); PG8_BAR; PG8_SCHED;
        }
        if constexpr (ALIGN_EPI) { if (wr == 0) PG8_BAR; }
        { int l2 = lane_id(); asm volatile("" : "+v"(l2)); E(acc, cur, wr, wc, l2 & 15, (l2 >> 4) & 3); }
        if (!has_next) break;
#pragma unroll
        for (int a = 0; a < 2; ++a)
#pragma unroll
            for (int b = 0; b < 2; ++b)
#pragma unroll
                for (int m = 0; m < 4; ++m)
#pragma unroll
                    for (int n = 0; n < 2; ++n) acc[a][b][m][n] = (f32x4){0.f, 0.f, 0.f, 0.f};
        cur = nxt; cA = nA; cB = nB; ++ui;
        if constexpr (ALIGN_EPI) { if (wr == 1) PG8_BAR; }
    }
    PG8_WAIT_V(0);
    if constexpr (!ALIGN_EPI) { if (wr == 0) PG8_BAR; }
    PG8_BAR;
#undef PG8_SA
#undef PG8_SB
#undef PG8_STAGE
#undef PG8_LDA
#undef PG8_LDB
#undef PG8_MMA
#undef PG8_WAIT_V
#undef PG8_WAIT_L
#undef PG8_BAR
#undef PG8_SCHED
}

typedef f32x4 Acc[2][2][4][2];

__device__ __forceinline__ u32x4 pack8(const float (&v)[8]) { u32x4 w; w.x = cvtpk(v[0], v[1]); w.y = cvtpk(v[2], v[3]); w.z = cvtpk(v[4], v[5]); w.w = cvtpk(v[6], v[7]); return w; }

struct EpiZ {
    bf16_t* Z; const float* tab; const float* qn; const float* kn;
    template <int TYPE> __device__ __forceinline__ void run(const Acc& acc, const Unit& u, int wr, int wc, int fr, int fq) const {
        asm volatile("" : "+v"(fr), "+v"(fq));
        const int colbase = u.pn * 256 + wc * 64 + 8 * fq;
        float g[2][8];
        if (TYPE == 4 || TYPE == 5) { const float* gp = (TYPE == 4) ? qn : kn; const float sc = (TYPE == 4) ? 0.18033688011112042f : 1.0f;
#pragma unroll
            for (int bj = 0; bj < 2; ++bj)
#pragma unroll
                for (int j = 0; j < 8; ++j) g[bj][j] = gp[32 * bj + 8 * fq + j] * sc; }
#pragma unroll
        for (int ai = 0; ai < 2; ++ai)
#pragma unroll
            for (int m = 0; m < 4; ++m) {
                const int row = u.pm * 256 + ai * 128 + wr * 64 + m * 16 + fr;
                float v[2][8];
#pragma unroll
                for (int bj = 0; bj < 2; ++bj)
#pragma unroll
                    for (int n = 0; n < 2; ++n)
#pragma unroll
                        for (int i = 0; i < 4; ++i) v[bj][4 * n + i] = acc[ai][bj][m][n][i];
                if (TYPE == 0 || TYPE == 1) {
                    const int pos = row & (SEQ - 1);
                    const f32x4* tp = (const f32x4*)(tab + ((size_t)pos * 32 + 8 * fq) * 2);
                    const float lgp = lg2gamma(((u.pn & 1) << 2) + wc) * (float)pos;
                    const float sc = (TYPE == 1) ? 0.125f * __builtin_amdgcn_exp2f(-lgp) : __builtin_amdgcn_exp2f(lgp);
#pragma unroll
                    for (int jj = 0; jj < 4; ++jj) { const f32x4 cs = tp[jj];
                        { const float t1 = v[0][2 * jj], t2 = v[1][2 * jj]; v[0][2 * jj] = (t1 * cs.x - t2 * cs.y) * sc; v[1][2 * jj] = (t1 * cs.y + t2 * cs.x) * sc; }
                        { const float t1 = v[0][2 * jj + 1], t2 = v[1][2 * jj + 1]; v[0][2 * jj + 1] = (t1 * cs.z - t2 * cs.w) * sc; v[1][2 * jj + 1] = (t1 * cs.w + t2 * cs.z) * sc; } }
                }
                if (TYPE == 3) {
#pragma unroll
                    for (int bj = 0; bj < 2; ++bj)
#pragma unroll
                        for (int j = 0; j < 8; ++j) { const float x = v[bj][j]; v[bj][j] = x * __builtin_amdgcn_rcpf(1.0f + __builtin_amdgcn_exp2f(-1.4426950408889634f * x)); }
                }
                if (TYPE == 4 || TYPE == 5) {
                    float ss = 0.f;
#pragma unroll
                    for (int bj = 0; bj < 2; ++bj)
#pragma unroll
                        for (int j = 0; j < 8; ++j) ss += v[bj][j] * v[bj][j];
                    ss = quad_sum(ss);
                    const float r = rsqrtf(ss * (1.0f / 64.0f) + EPS);
#pragma unroll
                    for (int bj = 0; bj < 2; ++bj)
#pragma unroll
                        for (int j = 0; j < 8; ++j) v[bj][j] = v[bj][j] * r * g[bj][j];
                }
                bf16_t* rowp = Z + (size_t)row * DIN + colbase;
                *(u32x4*)(rowp) = pack8(v[0]); *(u32x4*)(rowp + 32) = pack8(v[1]);
            }
    }
    __device__ __forceinline__ void operator()(const Acc& acc, const Unit& u, int wr, int wc, int fr, int fq) const {
        const int pn = u.pn;
        if (pn < 2) run<0>(acc, u, wr, wc, fr, fq);
        else if (pn < 4) run<1>(acc, u, wr, wc, fr, fq);
        else if (pn < 8) run<2>(acc, u, wr, wc, fr, fq);
        else if (pn < 12) run<3>(acc, u, wr, wc, fr, fq);
        else if (pn < 16) run<4>(acc, u, wr, wc, fr, fq);
        else if (pn < 20) run<5>(acc, u, wr, wc, fr, fq);
        else if (pn < 24) run<2>(acc, u, wr, wc, fr, fq);
        else run<3>(acc, u, wr, wc, fr, fq);
    }
};
struct EpiBf {
    bf16_t* O; int ldc;
    __device__ __forceinline__ void operator()(const Acc& acc, const Unit& u, int wr, int wc, int fr, int fq) const {
        asm volatile("" : "+v"(fr), "+v"(fq));
        const int colbase = u.pn * 256 + wc * 64 + 8 * fq;
#pragma unroll
        for (int ai = 0; ai < 2; ++ai)
#pragma unroll
            for (int m = 0; m < 4; ++m) {
                const int row = u.pm * 256 + ai * 128 + wr * 64 + m * 16 + fr;
#pragma unroll
                for (int bj = 0; bj < 2; ++bj) { float v[8];
#pragma unroll
                    for (int n = 0; n < 2; ++n)
#pragma unroll
                        for (int i = 0; i < 4; ++i) v[4 * n + i] = acc[ai][bj][m][n][i];
                    *(u32x4*)(O + (size_t)row * ldc + colbase + 32 * bj) = pack8(v); }
            }
    }
};
struct EpiH {
    const float* x; float* out; bf16_t* HB; float* rowss;
    __device__ __forceinline__ void operator()(const Acc& acc, const Unit& u, int wr, int wc, int fr, int fq) const {
        asm volatile("" : "+v"(fr), "+v"(fq));
        const int colbase = u.pn * 256 + wc * 64 + 8 * fq;
#pragma unroll
        for (int ai = 0; ai < 2; ++ai) {
            f32x4 xv[4][2][2];
#pragma unroll
            for (int m = 0; m < 4; ++m) { const size_t off = (size_t)(u.pm * 256 + ai * 128 + wr * 64 + m * 16 + fr) * DM + colbase;
#pragma unroll
                for (int bj = 0; bj < 2; ++bj) { xv[m][bj][0] = __builtin_nontemporal_load((const f32x4*)(x + off + 32 * bj)); xv[m][bj][1] = __builtin_nontemporal_load((const f32x4*)(x + off + 32 * bj + 4)); } }
#pragma unroll
            for (int m = 0; m < 4; ++m) {
                const int row = u.pm * 256 + ai * 128 + wr * 64 + m * 16 + fr;
                float ss = 0.f;
#pragma unroll
                for (int bj = 0; bj < 2; ++bj) {
                    const size_t off = (size_t)row * DM + colbase + 32 * bj;
                    const f32x4 h0 = xv[m][bj][0] + acc[ai][bj][m][0], h1 = xv[m][bj][1] + acc[ai][bj][m][1];
                    u32x4 w; w.x = cvtpk(h0.x, h0.y); w.y = cvtpk(h0.z, h0.w); w.z = cvtpk(h1.x, h1.y); w.w = cvtpk(h1.z, h1.w);
                    *(u32x4*)(HB + off) = w;
                    ss += (h0.x * h0.x + h0.y * h0.y) + (h0.z * h0.z + h0.w * h0.w) + (h1.x * h1.x + h1.y * h1.y) + (h1.z * h1.z + h1.w * h1.w);
                }
                ss = quad_sum(ss);
                if (fq == 0) atomicAdd(rowss + row, ss);
            }
        }
    }
};
struct EpiOut {
    const bf16_t* hin; float* out; const bf16_t* PP; const float* rowss;
    __device__ __forceinline__ void operator()(const Acc& acc, const Unit& u, int wr, int wc, int fr, int fq) const {
        asm volatile("" : "+v"(fr), "+v"(fq));
        const int colbase = u.pn * 256 + wc * 64 + 8 * fq;
#pragma unroll
        for (int ai = 0; ai < 2; ++ai) {
            f32x4 hv[4][2][2]; u32x4 pw[4][2]; float rsv[4];
#pragma unroll
            for (int m = 0; m < 4; ++m) { const int row = u.pm * 256 + ai * 128 + wr * 64 + m * 16 + fr; const size_t off = (size_t)row * DM + colbase;
                rsv[m] = rowss[row];
#pragma unroll
                for (int bj = 0; bj < 2; ++bj) { const u32x4 hw = __builtin_nontemporal_load((const u32x4*)(hin + off + 32 * bj));
                    hv[m][bj][0] = (f32x4){bflo(hw.x), bfhi(hw.x), bflo(hw.y), bfhi(hw.y)}; hv[m][bj][1] = (f32x4){bflo(hw.z), bfhi(hw.z), bflo(hw.w), bfhi(hw.w)};
                    pw[m][bj] = __builtin_nontemporal_load((const u32x4*)(PP + off + 32 * bj)); } }
#pragma unroll
            for (int m = 0; m < 4; ++m) {
                const int row = u.pm * 256 + ai * 128 + wr * 64 + m * 16 + fr;
                const float rs = rsqrtf(rsv[m] * (1.0f / DM) + EPS) * -1.4426950408889634f;
#pragma unroll
                for (int bj = 0; bj < 2; ++bj) {
                    const size_t off = (size_t)row * DM + colbase + 32 * bj;
                    f32x4 h0 = hv[m][bj][0], h1 = hv[m][bj][1];
                    const u32x4 p4 = pw[m][bj];
                    const f32x4 a0 = acc[ai][bj][m][0], a1 = acc[ai][bj][m][1];
                    h0.x += bflo(p4.x) * __builtin_amdgcn_rcpf(1.0f + __builtin_amdgcn_exp2f(a0.x * rs));
                    h0.y += bfhi(p4.x) * __builtin_amdgcn_rcpf(1.0f + __builtin_amdgcn_exp2f(a0.y * rs));
                    h0.z += bflo(p4.y) * __builtin_amdgcn_rcpf(1.0f + __builtin_amdgcn_exp2f(a0.z * rs));
                    h0.w += bfhi(p4.y) * __builtin_amdgcn_rcpf(1.0f + __builtin_amdgcn_exp2f(a0.w * rs));
                    h1.x += bflo(p4.z) * __builtin_amdgcn_rcpf(1.0f + __builtin_amdgcn_exp2f(a1.x * rs));
                    h1.y += bfhi(p4.z) * __builtin_amdgcn_rcpf(1.0f + __builtin_amdgcn_exp2f(a1.y * rs));
                    h1.z += bflo(p4.w) * __builtin_amdgcn_rcpf(1.0f + __builtin_amdgcn_exp2f(a1.z * rs));
                    h1.w += bfhi(p4.w) * __builtin_amdgcn_rcpf(1.0f + __builtin_amdgcn_exp2f(a1.w * rs));
                    *(f32x4*)(out + off) = h0; *(f32x4*)(out + off + 4) = h1;
                }
            }
        }
    }
};
}

constexpr int ATT_TILE = 2 * 8192 + 64 * 288;
constexpr int ATT_BUF = 2 * ATT_TILE;
template <bool DIFF>
__device__ __forceinline__ void attn_item(LAS unsigned char* lds, const bf16_t* Z, bf16_t* MIX, int b, int h, int t, float lam, float shift, const float* gain, int tid, int wid, int lane) {
    constexpr int NC = DIFF ? 2 : 1;
    lane = lane_id(); asm volatile("" : "+v"(lane)); tid = wid * 64 + lane;
    const int q16 = lane & 15, quad = lane >> 4;
    const int row0 = b * SEQ + 128 * t + 16 * wid;
    const int cq = 2 * t + (wid >> 2), nkt = 2 * t + 2;
    const int qcol = DIFF ? (3072 + 128 * h) : (64 * h);
    const int kcol = DIFF ? (4096 + 128 * h) : (512 + 64 * h);
    const int vcol = DIFF ? (5120 + 128 * h) : (1024 + 128 * h);
    const int gcol = DIFF ? (6144 + 128 * h) : (2048 + 128 * h);
    const float lg = lg2gamma(h);
    bf16x8 qf[NC][2];
    { const bf16_t* qrow = Z + (size_t)(row0 + q16) * DIN + qcol;
#pragma unroll
      for (int c = 0; c < NC; ++c)
#pragma unroll
          for (int ds = 0; ds < 2; ++ds) qf[c][ds] = *(const bf16x8*)(qrow + 64 * c + 32 * ds + 8 * quad); }
    f32x4 O[NC][8]; float l[NC];
#pragma unroll
    for (int c = 0; c < NC; ++c) { l[c] = 0.f;
#pragma unroll
        for (int eb = 0; eb < 8; ++eb) O[c][eb] = (f32x4){0.f, 0.f, 0.f, 0.f}; }
    const char* kbase = (const char*)(Z + (size_t)(b * SEQ) * DIN + kcol);
    const char* vbase = (const char*)(Z + (size_t)(b * SEQ) * DIN + vcol);
    const unsigned krow = (unsigned)(8 * wid + (lane >> 3));
    const unsigned kso = (krow * DIN + 8u * ((unsigned)(lane & 7) ^ (krow & 7u))) * 2u;
    const unsigned vrow = (unsigned)(4 * wid + (lane >> 4));
    const unsigned vso = (vrow * DIN + 8u * (2u * ((((unsigned)lane & 15u) >> 1) ^ (vrow & 7u)) + ((unsigned)lane & 1u))) * 2u;
    constexpr int ATT_RING = 32768;
#define ATT_DMA(kt, bi) do { const size_t _o = (size_t)(kt) * (64 * DIN * 2); \
        unsigned long long _kb = (unsigned long long)(kbase + _o); asm volatile("" : "+s"(_kb)); unsigned long long _vb = (unsigned long long)(vbase + _o); asm volatile("" : "+s"(_vb)); \
        unsigned long long _vb2 = _vb + 32 * DIN * 2; asm volatile("" : "+s"(_vb2)); \
        LAS unsigned char* _bp = lds + (bi) * ATT_RING + 1024 * wid; \
        _Pragma("unroll") for (int c = 0; c < NC; ++c) __builtin_amdgcn_global_load_lds((const GAS unsigned*)((const GAS char*)_kb + kso + 128 * c), (LAS unsigned*)(_bp + c * 8192), 16, 0, 0); \
        __builtin_amdgcn_global_load_lds((const GAS unsigned*)((const GAS char*)_vb + vso), (LAS unsigned*)(_bp + 16384), 16, 0, 0); \
        __builtin_amdgcn_global_load_lds((const GAS unsigned*)((const GAS char*)_vb2 + vso), (LAS unsigned*)(_bp + 16384 + 8192), 16, 0, 0); } while (0)
#define ATT_WAITBAR_ALL() asm volatile("s_waitcnt vmcnt(0) lgkmcnt(0)\n\ts_barrier" ::: "memory")
#define ATT_WAITBAR_ONE() do { if (DIFF) asm volatile("s_waitcnt vmcnt(4) lgkmcnt(0)\n\ts_barrier" ::: "memory"); else asm volatile("s_waitcnt vmcnt(3) lgkmcnt(0)\n\ts_barrier" ::: "memory"); } while (0)
    asm volatile("s_waitcnt lgkmcnt(0)\n\ts_barrier" ::: "memory");
    ATT_DMA(0, 0); ATT_DMA(1, 1);
    ATT_WAITBAR_ONE();
    const unsigned kfo = (unsigned)(q16 * 128), ksw = (unsigned)(q16 & 7);
    const unsigned vrr = (unsigned)(4 * quad + (q16 >> 2)), vx32 = (vrr & 7u) * 32u, vb0 = 16384u + vrr * 256u + 8u * (unsigned)(q16 & 3);
    const float iq = (float)(128 * t + 16 * wid + q16);
    int bcur = 0;
    for (int kt = 0; kt < nkt; ++kt) {
        const int bnx = (bcur == 2) ? 0 : bcur + 1, bn2 = (bnx == 2) ? 0 : bnx + 1;
        const bool more2 = (kt + 2 < nkt);
        if (more2) ATT_DMA(kt + 2, bn2);
        if (kt <= cq) {
            LAS unsigned char* bp = lds + bcur * ATT_RING;
            const float msk = 0.f;
            const float sinit = DIFF ? (msk - shift) : 0.f;
            bf16x8 kfA[8], kfB[8]; s16x4 vAl[8], vAh[8], vBl[8], vBh[8];
            f32x4 s0[4], s1[4];
            bf16x8 P[NC][2];
            const unsigned bpa = (unsigned)(size_t)bp;
#define ATT_KREAD(dst, c) do { _Pragma("unroll") for (int kb = 0; kb < 4; ++kb) _Pragma("unroll") for (int ds = 0; ds < 2; ++ds) \
                dst[kb * 2 + ds] = *(const LAS bf16x8*)(bp + (c) * 8192 + kb * 2048 + kfo + (((unsigned)(4 * ds + quad) ^ ksw) * 16)); } while (0)
#define ATT_VISSUE(lo_, hi_, eb0) do { _Pragma("unroll") for (int e = 0; e < 4; ++e) { const unsigned _a = bpa + vb0 + (((unsigned)((eb0) + e) * 32u) ^ vx32); \
                asm volatile("ds_read_b64_tr_b16 %0, %1 offset:0"     : "=&v"(lo_[e * 2 + 0]) : "v"(_a)); \
                asm volatile("ds_read_b64_tr_b16 %0, %1 offset:4096"  : "=&v"(hi_[e * 2 + 0]) : "v"(_a)); \
                asm volatile("ds_read_b64_tr_b16 %0, %1 offset:8192"  : "=&v"(lo_[e * 2 + 1]) : "v"(_a)); \
                asm volatile("ds_read_b64_tr_b16 %0, %1 offset:12288" : "=&v"(hi_[e * 2 + 1]) : "v"(_a)); } } while (0)
#define ATT_W4(N_, lo_, hi_, e_) asm volatile("s_waitcnt lgkmcnt(" #N_ ")" : "+v"(lo_[2 * (e_)]), "+v"(hi_[2 * (e_)]), "+v"(lo_[2 * (e_) + 1]), "+v"(hi_[2 * (e_) + 1]))
#define ATT_VWAIT15(lo_, hi_) asm volatile("s_waitcnt lgkmcnt(15)" : "+v"(lo_[0]), "+v"(lo_[1]), "+v"(lo_[2]), "+v"(lo_[3]), "+v"(lo_[4]), "+v"(lo_[5]), "+v"(lo_[6]), "+v"(lo_[7]), \
                "+v"(hi_[0]), "+v"(hi_[1]), "+v"(hi_[2]), "+v"(hi_[3]), "+v"(hi_[4]), "+v"(hi_[5]), "+v"(hi_[6]), "+v"(hi_[7]))
#define ATT_VWAIT(lo_, hi_) asm volatile("s_waitcnt lgkmcnt(0)" : "+v"(lo_[0]), "+v"(lo_[1]), "+v"(lo_[2]), "+v"(lo_[3]), "+v"(lo_[4]), "+v"(lo_[5]), "+v"(lo_[6]), "+v"(lo_[7]), \
                "+v"(hi_[0]), "+v"(hi_[1]), "+v"(hi_[2]), "+v"(hi_[3]), "+v"(hi_[4]), "+v"(hi_[5]), "+v"(hi_[6]), "+v"(hi_[7]))
#define ATT_SMMA(sv, kf, c) do { _Pragma("unroll") for (int kb = 0; kb < 4; ++kb) { sv[kb] = (f32x4){sinit, sinit, sinit, sinit}; _Pragma("unroll") for (int ds = 0; ds < 2; ++ds) \
                sv[kb] = __builtin_amdgcn_mfma_f32_16x16x32_bf16(kf[kb * 2 + ds], qf[c][ds], sv[kb], 0, 0, 0); } } while (0)
#define ATT_SOFT(sv, c) do { _Pragma("unroll") for (int kb = 0; kb < 4; ++kb) _Pragma("unroll") for (int i = 0; i < 4; ++i) { \
                if (DIFF) { const float p = __builtin_amdgcn_exp2f(sv[kb][i]); sv[kb][i] = p; l[c] += p; } \
                else if (kt == cq) { const float dj = (float)(64 * kt + 16 * kb + 4 * quad + i) - iq; if (dj > 0.f) sv[kb][i] = sv[kb][i] * __builtin_amdgcn_exp2f(2.0f * lg * dj); } } \
                _Pragma("unroll") for (int ks = 0; ks < 2; ++ks) { u32x4 w; w.x = cvtpk(sv[2 * ks][0], sv[2 * ks][1]); w.y = cvtpk(sv[2 * ks][2], sv[2 * ks][3]); w.z = cvtpk(sv[2 * ks + 1][0], sv[2 * ks + 1][1]); w.w = cvtpk(sv[2 * ks + 1][2], sv[2 * ks + 1][3]); \
                    P[c][ks] = __builtin_bit_cast(bf16x8, w); } } while (0)
#define ATT_PV(c, lo_, hi_, eb0) do { _Pragma("unroll") for (int e = 0; e < 4; ++e) _Pragma("unroll") for (int ks = 0; ks < 2; ++ks) \
                O[c][(eb0) + e] = __builtin_amdgcn_mfma_f32_16x16x32_bf16(__builtin_shufflevector(lo_[e * 2 + ks], hi_[e * 2 + ks], 0, 1, 2, 3, 4, 5, 6, 7), P[c][ks], O[c][(eb0) + e], 0, 0, 0); } while (0)
#define ATT_PV1(c, lo_, hi_, eb0, e) do { _Pragma("unroll") for (int ks = 0; ks < 2; ++ks) \
                O[c][(eb0) + (e)] = __builtin_amdgcn_mfma_f32_16x16x32_bf16(__builtin_shufflevector(lo_[(e) * 2 + ks], hi_[(e) * 2 + ks], 0, 1, 2, 3, 4, 5, 6, 7), P[c][ks], O[c][(eb0) + (e)], 0, 0, 0); } while (0)
#define ATT_PVW(c, lo_, hi_, eb0) do { ATT_W4(12, lo_, hi_, 0); ATT_PV1(c, lo_, hi_, eb0, 0); ATT_W4(8, lo_, hi_, 1); ATT_PV1(c, lo_, hi_, eb0, 1); \
                ATT_W4(4, lo_, hi_, 2); ATT_PV1(c, lo_, hi_, eb0, 2); ATT_W4(0, lo_, hi_, 3); ATT_PV1(c, lo_, hi_, eb0, 3); } while (0)
#define ATT_SB __builtin_amdgcn_sched_barrier(0)
            ATT_KREAD(kfA, 0); ATT_SB;
            if (DIFF) { ATT_KREAD(kfB, NC - 1); ATT_SMMA(s0, kfA, 0); ATT_SB;
                        ATT_VISSUE(vAl, vAh, 0); ATT_SMMA(s1, kfB, NC - 1); ATT_SOFT(s0, 0); ATT_SB;
                        ATT_SOFT(s1, NC - 1); ATT_PVW(0, vAl, vAh, 0); ATT_SB;
                        ATT_VISSUE(vBl, vBh, 4); ATT_PV(NC - 1, vAl, vAh, 0); ATT_SB;
                        ATT_PVW(0, vBl, vBh, 4); ATT_PV(NC - 1, vBl, vBh, 4); ATT_SB; }
            else      { ATT_VISSUE(vAl, vAh, 0); ATT_SMMA(s0, kfA, 0); ATT_SB;
                        ATT_VISSUE(vBl, vBh, 4); ATT_SOFT(s0, 0); ATT_SB;
                        ATT_VWAIT15(vAl, vAh); ATT_PV(0, vAl, vAh, 0); ATT_PVW(0, vBl, vBh, 4); ATT_SB; }
#undef ATT_KREAD
#undef ATT_VISSUE
#undef ATT_VWAIT
#undef ATT_VWAIT15
#undef ATT_W4
#undef ATT_PV1
#undef ATT_PVW
#undef ATT_SMMA
#undef ATT_SOFT
#undef ATT_PV
#undef ATT_SB
        }
        if (kt + 1 < nkt) { if (more2) ATT_WAITBAR_ONE(); else ATT_WAITBAR_ALL(); }
        bcur = bnx;
    }
#undef ATT_DMA
#undef ATT_WAITBAR_ALL
#undef ATT_WAITBAR_ONE
    float inv0 = 1.f, inv1 = 0.f;
    if (DIFF) {
#pragma unroll
        for (int c = 0; c < NC; ++c) l[c] = quad_sum(l[c]);
        inv0 = 1.0f / l[0]; inv1 = lam / l[NC - 1];
    }
    float ss = 0.f;
#pragma unroll
    for (int eb = 0; eb < 8; ++eb)
#pragma unroll
        for (int i = 0; i < 4; ++i) { float v = O[0][eb][i] * inv0; if (DIFF) v -= O[NC - 1][eb][i] * inv1; O[0][eb][i] = v; ss += v * v; }
    ss = quad_sum(ss);
    const float r = rsqrtf(ss * (1.0f / 128.0f) + EPS) * (DIFF ? 0.8f : 1.0f);
    const int row = row0 + q16;
    const bf16_t* gp = Z + (size_t)row * DIN + gcol + 4 * quad;
    bf16_t* op = MIX + (size_t)row * DM + (DIFF ? 1024 : 0) + 128 * h + 4 * quad;
#pragma unroll
    for (int eb = 0; eb < 8; ++eb) {
        const u32x2 gw = *(const u32x2*)(gp + 16 * eb);
        const f32x4 gn = *(const f32x4*)(gain + 16 * eb + 4 * quad);
        u32x2 w; w.x = cvtpk(O[0][eb][0] * r * gn.x * bflo(gw.x), O[0][eb][1] * r * gn.y * bfhi(gw.x));
        w.y = cvtpk(O[0][eb][2] * r * gn.z * bflo(gw.y), O[0][eb][3] * r * gn.w * bfhi(gw.y));
        *(u32x2*)(op + 16 * eb) = w;
    }
}

__device__ __forceinline__ void ret_pair(LAS unsigned char* lds, const bf16_t* Z, bf16_t* MIX, int b, int h, int tA, int tB, const float* gain, int wid) {
    int lane = lane_id(); asm volatile("" : "+v"(lane));
    const int q16 = lane & 15, quad = lane >> 4;
    const int rowA0 = b * SEQ + 128 * tA + 16 * wid, rowB0 = b * SEQ + 128 * tB + 16 * wid;
    const int cqA = 2 * tA + (wid >> 2), cqB = 2 * tB + (wid >> 2), nkt = 2 * tA + 2;
    const int qcol = 64 * h, kcol = 512 + 64 * h, vcol = 1024 + 128 * h, gcol = 2048 + 128 * h;
    const float lg = lg2gamma(h);
    bf16x8 qfA[2], qfB[2];
    { const bf16_t* qa = Z + (size_t)(rowA0 + q16) * DIN + qcol; const bf16_t* qb = Z + (size_t)(rowB0 + q16) * DIN + qcol;
#pragma unroll
      for (int ds = 0; ds < 2; ++ds) { qfA[ds] = *(const bf16x8*)(qa + 32 * ds + 8 * quad); qfB[ds] = *(const bf16x8*)(qb + 32 * ds + 8 * quad); } }
    f32x4 OA[8], OB[8];
#pragma unroll
    for (int eb = 0; eb < 8; ++eb) { OA[eb] = (f32x4){0.f, 0.f, 0.f, 0.f}; OB[eb] = OA[eb]; }
    const char* kbase = (const char*)(Z + (size_t)(b * SEQ) * DIN + kcol);
    const char* vbase = (const char*)(Z + (size_t)(b * SEQ) * DIN + vcol);
    const unsigned krow = (unsigned)(8 * wid + (lane >> 3));
    const unsigned kso = (krow * DIN + 8u * ((unsigned)(lane & 7) ^ (krow & 7u))) * 2u;
    const unsigned vrow = (unsigned)(4 * wid + (lane >> 4));
    const unsigned vso = (vrow * DIN + 8u * (2u * ((((unsigned)lane & 15u) >> 1) ^ (vrow & 7u)) + ((unsigned)lane & 1u))) * 2u;
    constexpr int RING = 32768;
#define RP_DMA(kt, bi) do { const size_t _o = (size_t)(kt) * (64 * DIN * 2); \
        unsigned long long _kb = (unsigned long long)(kbase + _o); asm volatile("" : "+s"(_kb)); unsigned long long _vb = (unsigned long long)(vbase + _o); asm volatile("" : "+s"(_vb)); \
        unsigned long long _vb2 = _vb + 32 * DIN * 2; asm volatile("" : "+s"(_vb2)); \
        LAS unsigned char* _bp = lds + (bi) * RING + 1024 * wid; \
        __builtin_amdgcn_global_load_lds((const GAS unsigned*)((const GAS char*)_kb + kso), (LAS unsigned*)(_bp), 16, 0, 0); \
        __builtin_amdgcn_global_load_lds((const GAS unsigned*)((const GAS char*)_vb + vso), (LAS unsigned*)(_bp + 16384), 16, 0, 0); \
        __builtin_amdgcn_global_load_lds((const GAS unsigned*)((const GAS char*)_vb2 + vso), (LAS unsigned*)(_bp + 16384 + 8192), 16, 0, 0); } while (0)
    asm volatile("s_waitcnt lgkmcnt(0)\n\ts_barrier" ::: "memory");
    RP_DMA(0, 0); RP_DMA(1, 1);
    asm volatile("s_waitcnt vmcnt(3) lgkmcnt(0)\n\ts_barrier" ::: "memory");
    const unsigned kfo = (unsigned)(q16 * 128), ksw = (unsigned)(q16 & 7);
    const unsigned vrr = (unsigned)(4 * quad + (q16 >> 2)), vx32 = (vrr & 7u) * 32u, vb0 = 16384u + vrr * 256u + 8u * (unsigned)(q16 & 3);
    const float iqA = (float)(128 * tA + 16 * wid + q16), iqB = (float)(128 * tB + 16 * wid + q16);
#define RP_VISSUE(lo_, hi_, eb0) do { _Pragma("unroll") for (int e = 0; e < 2; ++e) { const unsigned _a = bpa + vb0 + (((unsigned)((eb0) + e) * 32u) ^ vx32); \
                asm volatile("ds_read_b64_tr_b16 %0, %1 offset:0"     : "=&v"(lo_[e * 2 + 0]) : "v"(_a)); \
                asm volatile("ds_read_b64_tr_b16 %0, %1 offset:4096"  : "=&v"(hi_[e * 2 + 0]) : "v"(_a)); \
                asm volatile("ds_read_b64_tr_b16 %0, %1 offset:8192"  : "=&v"(lo_[e * 2 + 1]) : "v"(_a)); \
                asm volatile("ds_read_b64_tr_b16 %0, %1 offset:12288" : "=&v"(hi_[e * 2 + 1]) : "v"(_a)); } } while (0)
#define RP_VWAIT(N_, lo_, hi_) asm volatile("s_waitcnt lgkmcnt(" #N_ ")" : "+v"(lo_[0]), "+v"(lo_[1]), "+v"(lo_[2]), "+v"(lo_[3]), "+v"(hi_[0]), "+v"(hi_[1]), "+v"(hi_[2]), "+v"(hi_[3]))
#define RP_SMMA(sv, qf_) do { _Pragma("unroll") for (int kb = 0; kb < 4; ++kb) { sv[kb] = (f32x4){0.f, 0.f, 0.f, 0.f}; _Pragma("unroll") for (int ds = 0; ds < 2; ++ds) \
                sv[kb] = __builtin_amdgcn_mfma_f32_16x16x32_bf16(kf[kb * 2 + ds], qf_[ds], sv[kb], 0, 0, 0); } } while (0)
#define RP_SOFT(sv, PP_, cq_, iq_) do { if (kt == (cq_)) { _Pragma("unroll") for (int kb = 0; kb < 4; ++kb) _Pragma("unroll") for (int i = 0; i < 4; ++i) { \
                const float dj = (float)(64 * kt + 16 * kb + 4 * quad + i) - (iq_); if (dj > 0.f) sv[kb][i] = sv[kb][i] * __builtin_amdgcn_exp2f(2.0f * lg * dj); } } \
                _Pragma("unroll") for (int ks = 0; ks < 2; ++ks) { u32x4 w; w.x = cvtpk(sv[2 * ks][0], sv[2 * ks][1]); w.y = cvtpk(sv[2 * ks][2], sv[2 * ks][3]); w.z = cvtpk(sv[2 * ks + 1][0], sv[2 * ks + 1][1]); w.w = cvtpk(sv[2 * ks + 1][2], sv[2 * ks + 1][3]); \
                    PP_[ks] = __builtin_bit_cast(bf16x8, w); } } while (0)
#define RP_PV(OO_, PP_, lo_, hi_, eb0) do { _Pragma("unroll") for (int e = 0; e < 2; ++e) _Pragma("unroll") for (int ks = 0; ks < 2; ++ks) \
                OO_[(eb0) + e] = __builtin_amdgcn_mfma_f32_16x16x32_bf16(__builtin_shufflevector(lo_[e * 2 + ks], hi_[e * 2 + ks], 0, 1, 2, 3, 4, 5, 6, 7), PP_[ks], OO_[(eb0) + e], 0, 0, 0); } while (0)
#define RP_SB ((void)0)
#define RP_BODY(WITHB) do { LAS unsigned char* bp = lds + bcur * RING; const unsigned bpa = (unsigned)(size_t)bp; \
            bf16x8 PA[2], PB[2]; s16x4 xl[4], xh[4]; \
            { bf16x8 kf[8]; f32x4 sA[4]; \
              _Pragma("unroll") for (int kb = 0; kb < 4; ++kb) _Pragma("unroll") for (int ds = 0; ds < 2; ++ds) \
                kf[kb * 2 + ds] = *(const LAS bf16x8*)(bp + kb * 2048 + kfo + (((unsigned)(4 * ds + quad) ^ ksw) * 16)); \
              RP_SB; \
              RP_SMMA(sA, qfA); RP_SB; \
              RP_SOFT(sA, PA, cqA, iqA); if (WITHB) RP_SMMA(sA, qfB); RP_SB; \
              RP_VISSUE(xl, xh, 0); if (WITHB) RP_SOFT(sA, PB, cqB, iqB); RP_SB; } \
            RP_VWAIT(0, xl, xh); RP_PV(OA, PA, xl, xh, 0); if (WITHB) RP_PV(OB, PB, xl, xh, 0); RP_SB; \
            RP_VISSUE(xl, xh, 2); RP_VWAIT(0, xl, xh); RP_PV(OA, PA, xl, xh, 2); if (WITHB) RP_PV(OB, PB, xl, xh, 2); RP_SB; \
            RP_VISSUE(xl, xh, 4); RP_VWAIT(0, xl, xh); RP_PV(OA, PA, xl, xh, 4); if (WITHB) RP_PV(OB, PB, xl, xh, 4); RP_SB; \
            RP_VISSUE(xl, xh, 6); RP_VWAIT(0, xl, xh); RP_PV(OA, PA, xl, xh, 6); if (WITHB) RP_PV(OB, PB, xl, xh, 6); RP_SB; } while (0)
    int bcur = 0;
    for (int kt = 0; kt < nkt; ++kt) {
        const int bnx = (bcur == 2) ? 0 : bcur + 1, bn2 = (bnx == 2) ? 0 : bnx + 1;
        const bool more2 = (kt + 2 < nkt);
        if (more2) RP_DMA(kt + 2, bn2);
        if (kt <= cqA) {
            if (kt <= cqB) RP_BODY(true); else RP_BODY(false);
        }
        if (kt + 1 < nkt) { if (more2) asm volatile("s_waitcnt vmcnt(3) lgkmcnt(0)\n\ts_barrier" ::: "memory"); else asm volatile("s_waitcnt vmcnt(0) lgkmcnt(0)\n\ts_barrier" ::: "memory"); }
        bcur = bnx;
    }
#undef RP_DMA
#undef RP_VISSUE
#undef RP_VWAIT
#undef RP_SMMA
#undef RP_SOFT
#undef RP_PV
#undef RP_SB
#undef RP_BODY
    int lf = lane_id(); asm volatile("" : "+v"(lf)); const int q16f = lf & 15, quadf = (lf >> 4) & 3;
#pragma unroll
    for (int which = 0; which < 2; ++which) {
        f32x4 (&O)[8] = which ? OB : OA;
        float ss = 0.f;
#pragma unroll
        for (int eb = 0; eb < 8; ++eb)
#pragma unroll
            for (int i = 0; i < 4; ++i) ss += O[eb][i] * O[eb][i];
        ss = quad_sum(ss);
        const float r = rsqrtf(ss * (1.0f / 128.0f) + EPS);
        const int row = (which ? rowB0 : rowA0) + q16f;
        const bf16_t* gp = Z + (size_t)row * DIN + gcol + 4 * quadf;
        bf16_t* op = MIX + (size_t)row * DM + 128 * h + 4 * quadf;
#pragma unroll
        for (int eb = 0; eb < 8; ++eb) {
            const u32x2 gw = *(const u32x2*)(gp + 16 * eb);
            const f32x4 gn = *(const f32x4*)(gain + 16 * eb + 4 * quadf);
            u32x2 w; w.x = cvtpk(O[eb][0] * r * gn.x * bflo(gw.x), O[eb][1] * r * gn.y * bfhi(gw.x));
            w.y = cvtpk(O[eb][2] * r * gn.z * bflo(gw.y), O[eb][3] * r * gn.w * bfhi(gw.y));
            *(u32x2*)(op + 16 * eb) = w;
        }
    }
}

__device__ __forceinline__ void p0_transpose_item(const float* W, int K, int N, bf16_t* WT, const float* kscale, LAS float* scr, int item, int lane) {
    const int nblk = N / 32, kb = item / nblk, nb = item % nblk, k0 = 64 * kb, n0 = 32 * nb;
    const int n4 = (lane & 7) * 4, kr = lane >> 3;
    f32x4 v[8];
#pragma unroll
    for (int i = 0; i < 8; ++i) v[i] = __builtin_nontemporal_load((const f32x4*)(W + (size_t)(k0 + kr + 8 * i) * N + n0 + n4));
#pragma unroll
    for (int i = 0; i < 8; ++i) { const int kk = kr + 8 * i; const float sc = kscale ? kscale[k0 + kk] : 1.0f; LAS float* d = scr + kk * 33 + n4;
        d[0] = v[i].x * sc; d[1] = v[i].y * sc; d[2] = v[i].z * sc; d[3] = v[i].w * sc; }
    asm volatile("s_waitcnt lgkmcnt(0)" ::: "memory");
    const int c = lane & 7;
#pragma unroll
    for (int j = 0; j < 4; ++j) { const int n = (lane >> 3) + 8 * j; const LAS float* sp = scr + (8 * c) * 33 + n;
        u32x4 o; o.x = cvtpk(sp[0 * 33], sp[1 * 33]); o.y = cvtpk(sp[2 * 33], sp[3 * 33]); o.z = cvtpk(sp[4 * 33], sp[5 * 33]); o.w = cvtpk(sp[6 * 33], sp[7 * 33]);
        *(u32x4*)(WT + (size_t)(n0 + n) * K + k0 + 8 * c) = o; }
    asm volatile("s_waitcnt lgkmcnt(0)" ::: "memory");
}

#define XB_TMO      128
#define XB_XCNT(j)  (256  + 64 * (j))
#define XB_XSUB(j)  (1280 + 64 * (j))
#define XB_XGEN(j)  (2304 + 64 * (j))
#define XB_TOP      3328
#define XB_TOPGEN   3392
#define XCD_BAR_WORDS 3456
#define XB_SPIN_CAP (1u << 18)
__device__ __forceinline__ unsigned xb_ld(unsigned* p)              { return __hip_atomic_load(p, __ATOMIC_RELAXED, __HIP_MEMORY_SCOPE_AGENT); }
__device__ __forceinline__ unsigned xb_add(unsigned* p, unsigned v) { return __hip_atomic_fetch_add(p, v, __ATOMIC_RELAXED, __HIP_MEMORY_SCOPE_AGENT); }
__device__ __forceinline__ unsigned xb_xcc_id() { return (unsigned)__builtin_amdgcn_s_getreg((3 << 11) | 20) & 0xFu; }
#define XB_SPIN(cond, bar) do { unsigned _sp = 0; while (cond) { __builtin_amdgcn_s_sleep(1); \
    if ((++_sp & 255u) == 0u) { if (xb_ld(&(bar)[XB_TMO])) break; if (_sp > XB_SPIN_CAP) { atomicAdd(&(bar)[XB_TMO], 1u); break; } } } } while (0)
struct XcdBarrier { unsigned* bar; unsigned x; volatile LAS unsigned* st; int wid; };
__device__ __forceinline__ XcdBarrier xcd_barrier_post(unsigned* bar, volatile LAS unsigned* st) {
    XcdBarrier b; b.bar = bar; b.x = xb_xcc_id(); b.st = st; b.wid = 0;
    if (threadIdx.x == 0) (void)xb_add(&bar[XB_XCNT(b.x)], 1u);
    return b;
}
__device__ __forceinline__ void xcd_barrier_complete(unsigned* bar, unsigned x, unsigned& nloc, unsigned& nx) {
    const unsigned G = gridDim.x * gridDim.y * gridDim.z;
    unsigned sum, cnt, mine, sp = 0u;
    for (;;) {
        sum = 0u; cnt = 0u; mine = 0u;
#pragma unroll
        for (unsigned j = 0; j < 16; ++j) { const unsigned c = xb_ld(&bar[XB_XCNT(j)]); sum += c; cnt += (c > 0u) ? 1u : 0u; mine = (j == x) ? c : mine; }
        if (sum == G) break;
        __builtin_amdgcn_s_sleep(1);
        if ((++sp & 255u) == 0u) { if (xb_ld(&bar[XB_TMO])) break; if (sp > XB_SPIN_CAP) { atomicAdd(&bar[XB_TMO], 1u); break; } }
    }
    nloc = mine > 0u ? mine : 1u; nx = cnt > 0u ? cnt : 1u;
}
__device__ __forceinline__ void xcd_barrier(const XcdBarrier& b) {
    asm volatile("s_waitcnt vmcnt(0)" ::: "memory");
    __syncthreads();
    if (b.wid == 0 && lane_id() == 0) {
        unsigned* bar = b.bar;
        __builtin_amdgcn_s_waitcnt(0);
        unsigned nloc = b.st[0], nx = b.st[1];
        if (nloc == 0u) { xcd_barrier_complete(bar, b.x, nloc, nx); b.st[0] = nloc; b.st[1] = nx; }
        const unsigned old = xb_add(&bar[XB_XSUB(b.x)], 1u);
        const unsigned gen = old / nloc;
        if (old + 1u == (gen + 1u) * nloc) {
            __builtin_amdgcn_fence(__ATOMIC_RELEASE, "agent");
            asm volatile("s_waitcnt vmcnt(0)" ::: "memory");
            const unsigned og = xb_add(&bar[XB_TOP], 1u);
            const unsigned tg = og / nx;
            if (og + 1u == (tg + 1u) * nx) xb_add(&bar[XB_TOPGEN], 1u);
            else XB_SPIN(xb_ld(&bar[XB_TOPGEN]) == tg, bar);
            __builtin_amdgcn_fence(__ATOMIC_ACQUIRE, "agent");
            xb_add(&bar[XB_XGEN(b.x)], 1u);
            asm volatile("s_waitcnt vmcnt(0)" ::: "memory");
        } else {
            XB_SPIN(xb_ld(&bar[XB_XGEN(b.x)]) == gen, bar);
            __builtin_amdgcn_fence(__ATOMIC_ACQUIRE, "agent");
            asm volatile("s_waitcnt vmcnt(0)" ::: "memory");
        }
    }
    __syncthreads();
}

#ifndef N_LAUNCHES
#define N_LAUNCHES 1
#endif
#ifndef REP0
#define REP0 1
#endif
#ifndef REP1
#define REP1 1
#endif
#ifndef REP3
#define REP3 1
#endif
#ifndef REP4
#define REP4 1
#endif
#ifndef REP2
#define REP2 1
#endif
__device__ __forceinline__ const float* ld_uptr(const unsigned char* tblbase, int k) {
    const unsigned long long v = *(const GAS unsigned long long*)(tblbase + 8 * k);
    const unsigned lo = __builtin_amdgcn_readfirstlane((unsigned)v), hi = __builtin_amdgcn_readfirstlane((unsigned)(v >> 32));
    return (const float*)(((unsigned long long)hi << 32) | lo);
}
struct Args { const float* in[16]; float* out; unsigned char* ws; int ph_lo, ph_hi; };

__global__ void __launch_bounds__(NWAVES * 64, 2) fwd(Args args) {
    extern __shared__ __attribute__((aligned(16))) unsigned char lds_raw[];
    LAS unsigned char* lds = (LAS unsigned char*)lds_raw;
    const int wid = __builtin_amdgcn_readfirstlane((int)threadIdx.x >> 6);
    const int G = gridDim.x, bx = blockIdx.x;
    const int vcu = (G % 8 == 0) ? (bx % 8) * (G / 8) + bx / 8 : bx;
    unsigned char* ws = args.ws;
    const float* x = args.in[0]; const float* p = args.in[1]; const float* attn_norm = args.in[2]; const float* w_in = args.in[3];
    const float* ret_gn = args.in[4]; const float* diff_qn = args.in[5]; const float* diff_kn = args.in[6];
    const float* lq1 = args.in[7]; const float* lk1 = args.in[8]; const float* lq2 = args.in[9]; const float* lk2 = args.in[10];
    const float* subln = args.in[11]; const float* w_out = args.in[12]; const float* ple_norm = args.in[13];
    const float* w_gate = args.in[14]; const float* w_proj = args.in[15];
    float* out = args.out;
    float* rowss = (float*)(ws + WS_ROWSS); float* tab = (float*)(ws + WS_TAB);
    bf16_t* WinT = (bf16_t*)(ws + WS_WIN); bf16_t* WoutT = (bf16_t*)(ws + WS_WOUT); bf16_t* WgT = (bf16_t*)(ws + WS_WG); bf16_t* WpT = (bf16_t*)(ws + WS_WP);
    bf16_t* U = (bf16_t*)(ws + WS_U); bf16_t* MIX = (bf16_t*)(ws + WS_MIX); bf16_t* PB = (bf16_t*)(ws + WS_PB);
    bf16_t* Z = (bf16_t*)(ws + WS_Z); bf16_t* HB = (bf16_t*)(ws + WS_HB); bf16_t* PP = (bf16_t*)(ws + WS_PP);
    const int lo = args.ph_lo, hi = args.ph_hi;
    volatile LAS unsigned* MISC = (volatile LAS unsigned*)(lds + LDS_BYTES - 64);
    if (threadIdx.x < 16) MISC[threadIdx.x] = 0u;
    __syncthreads();
    XcdBarrier xbar; xbar.bar = (unsigned*)(ws + WS_BAR); xbar.x = 0; xbar.st = MISC; xbar.wid = wid;
    if (hi - lo > 1) { xbar = xcd_barrier_post((unsigned*)(ws + WS_BAR), MISC); xbar.wid = wid; }
#define IN(k) (lo <= (k) && (k) < hi)
#define SEAM(k) do { if (IN(k) && IN((k) + 1)) xcd_barrier(xbar); } while (0)

    for (int rep0 = 0; rep0 < REP0; ++rep0)
    if (IN(0)) {
        int lane = lane_id(); asm volatile("" : "+v"(lane)); const int tid = wid * 64 + lane;
        LAS float* scr = (LAS float*)(lds + wid * 16384);
        const int gw = vcu * NWAVES + wid, NGW = G * NWAVES;
        constexpr int I_IN = (DM / 64) * (DIN / 32), I_OUT = (DM / 64) * (DM / 32), I_G = I_OUT, I_P = (PLE / 64) * (DM / 32);
        constexpr int NITEMS = I_IN + I_P;
        for (int k = 0; ; ++k) {
            const int it = gw + k * NGW, m = gw + k * NGW;
            if (it >= NITEMS && m >= M) break;
            if (it < NITEMS) { if (it < I_IN) p0_transpose_item(w_in, DM, DIN, WinT, nullptr, scr, it, lane); else p0_transpose_item(w_proj, PLE, DM, WpT, nullptr, scr, it - I_IN, lane); }
            if (m < M) {
                const f32x4* xr = (const f32x4*)(x + (size_t)m * DM) + lane;
                f32x4 v[8]; float s = 0.f;
#pragma unroll
                for (int j = 0; j < 8; ++j) { v[j] = __builtin_nontemporal_load(xr + 64 * j); s += (v[j].x * v[j].x + v[j].y * v[j].y) + (v[j].z * v[j].z + v[j].w * v[j].w); }
                const float rs = rsqrtf(wave_sum(s) * (1.0f / DM) + EPS);
                u32x2* o8 = (u32x2*)(U + (size_t)m * DM) + lane;
#pragma unroll
                for (int j = 0; j < 8; ++j) { const f32x4 g = ((const f32x4*)attn_norm)[lane + 64 * j]; u32x2 w; w.x = cvtpk(v[j].x * rs * g.x, v[j].y * rs * g.y); w.y = cvtpk(v[j].z * rs * g.z, v[j].w * rs * g.w); o8[64 * j] = w; }
            }
        }
        const int gt = vcu * (NWAVES * 64) + tid, NGT = G * NWAVES * 64;
        for (int i = gt; i < M * PLE / 8; i += NGT) {
            const f32x4 a = __builtin_nontemporal_load((const f32x4*)p + 2 * i), b2 = __builtin_nontemporal_load((const f32x4*)p + 2 * i + 1);
            u32x4 w; w.x = cvtpk(a.x, a.y); w.y = cvtpk(a.z, a.w); w.z = cvtpk(b2.x, b2.y); w.w = cvtpk(b2.z, b2.w);
            ((u32x4*)PB)[i] = w;
        }
        for (int i = gt; i < SEQ * 32; i += NGT) {
            const int pos = i >> 5, k = i & 31;
            double f = 1.0; for (int q = 0; q < k; ++q) f *= 0.7498942093324559;
            const double rev = (double)pos * f * 0.15915494309189535;
            const float fr = (float)(rev - floor(rev));
            tab[2 * i] = __builtin_amdgcn_cosf(fr); tab[2 * i + 1] = __builtin_amdgcn_sinf(fr);
        }
        for (int i = gt; i < M; i += NGT) rowss[i] = 0.f;
        if (bx == 0 && tid < 17) ((const float**)(ws + WS_PTRS))[tid] = (tid < 16) ? args.in[tid] : (const float*)args.out;
    }
    SEAM(0);

    for (int rep1 = 0; rep1 < REP1; ++rep1)
    if (IN(1)) {
        const bool split = (G == 256); const int GG = split ? 224 : G;
        { pg8::Gemm g{U, WinT, M, DIN, DM}; pg8::StaticOrder S; S.init(M, DIN, GG, (bx < GG) ? bx : -1);
          pg8::EpiZ E{Z, tab, diff_qn, diff_kn};
          pg8::gemm_phase<pg8::EpiZ, true>(lds, g, S, E, wid); }
        { pg8::Gemm g{PB, WpT, M, DM, PLE}; pg8::StaticOrder S;
          if (split) S.init(M, DM, 32, bx - 224); else S.init(M, DM, G, bx);
          pg8::EpiBf E{PP, DM};
          pg8::gemm_phase<pg8::EpiBf, true>(lds, g, S, E, wid); }
        {
            int l3 = lane_id(); asm volatile("" : "+v"(l3));
            LAS float* scr = (LAS float*)(lds + wid * 16384);
            constexpr int I_OUT = (DM / 64) * (DM / 32);
            const int first = split ? 224 : 0, nw = (G - first) * NWAVES;
            if (bx >= first)
                for (int it = (bx - first) * NWAVES + wid; it < 2 * I_OUT; it += nw) {
                    if (it < I_OUT) p0_transpose_item(w_out, DM, DM, WoutT, nullptr, scr, it, l3);
                    else p0_transpose_item(w_gate, DM, DM, WgT, ple_norm, scr, it - I_OUT, l3);
                }
        }
    }
    SEAM(1);

    for (int rep2 = 0; rep2 < REP2; ++rep2)
    if (IN(2)) {
        unsigned char* wsp = ws; asm volatile("" : "+s"(wsp)); const unsigned char* tbl = wsp + WS_PTRS;
        const float* ret_gn = ld_uptr(tbl, 4); const float* diff_qn = ld_uptr(tbl, 5); const float* diff_kn = ld_uptr(tbl, 6); const float* lq1 = ld_uptr(tbl, 7); const float* lk1 = ld_uptr(tbl, 8);
        const float* lq2 = ld_uptr(tbl, 9); const float* lk2 = ld_uptr(tbl, 10); const float* subln = ld_uptr(tbl, 11);
        bf16_t* Z = (bf16_t*)(wsp + WS_Z); bf16_t* MIX = (bf16_t*)(wsp + WS_MIX);
        int lane2 = lane_id(); asm volatile("" : "+v"(lane2));
        const float d1 = wave_sum(lq1[lane2] * lk1[lane2]), d2 = wave_sum(lq2[lane2] * lk2[lane2]);
        float lam; { float lv = __expf(d1) - __expf(d2) + 0.2f; asm volatile("" : "+v"(lv)); lam = __uint_as_float(__builtin_amdgcn_readfirstlane(__float_as_uint(lv))); }
        const float mq = wave_max(fabsf(diff_qn[lane2])), mk = wave_max(fabsf(diff_kn[lane2]));
        float shift; { float sv = 11.541560327111707f * mq * mk; asm volatile("" : "+v"(sv)); shift = __uint_as_float(__builtin_amdgcn_readfirstlane(__float_as_uint(sv))); }
        for (int pi = vcu; pi < 256; pi += G) {
            const int bh = pi >> 3, tp = pi & 7, b = bh >> 3, h = bh & 7;
            attn_item<true>(lds, Z, MIX, b, h, 15 - tp, lam, shift, subln, 0, wid, 0);
            ret_pair(lds, Z, MIX, b, h, 15 - tp, tp, ret_gn + 128 * h, wid);
            attn_item<true>(lds, Z, MIX, b, h, tp, lam, shift, subln, 0, wid, 0);
        }
        __syncthreads();
    }
    SEAM(2);

    if (IN(3)) {
        unsigned char* wsp = ws; asm volatile("" : "+s"(wsp)); const unsigned char* tbl = wsp + WS_PTRS;
        const float* x = ld_uptr(tbl, 0); float* out = (float*)ld_uptr(tbl, 16);
        bf16_t* MIX = (bf16_t*)(wsp + WS_MIX); bf16_t* WoutT = (bf16_t*)(wsp + WS_WOUT); bf16_t* HB = (bf16_t*)(wsp + WS_HB); float* rowss = (float*)(wsp + WS_ROWSS);
        pg8::Gemm g{MIX, WoutT, M, DM, DM}; pg8::StaticOrder S; S.init(M, DM, G, bx);
#if REP3 > 1
        { pg8::EpiH E0{x, out, HB, rowss + 8192}; pg8::gemm_phase<pg8::EpiH, true>(lds, g, S, E0, wid); }
#endif
        pg8::EpiH E{x, out, HB, rowss};
        pg8::gemm_phase<pg8::EpiH, true>(lds, g, S, E, wid);
    }
    SEAM(3);

    if (IN(4)) {
        unsigned char* wsp = ws; asm volatile("" : "+s"(wsp)); const unsigned char* tbl = wsp + WS_PTRS;
        float* out = (float*)ld_uptr(tbl, 16);
        bf16_t* HB = (bf16_t*)(wsp + WS_HB); bf16_t* WgT = (bf16_t*)(wsp + WS_WG); bf16_t* PP = (bf16_t*)(wsp + WS_PP); float* rowss = (float*)(wsp + WS_ROWSS);
        pg8::Gemm g{HB, WgT, M, DM, DM}; pg8::StaticOrder S; S.init(M, DM, G, bx);
#if REP4 > 1
        { pg8::EpiOut E0{HB, (float*)(ws + WS_Z + 40 * MiB), PP, rowss}; pg8::gemm_phase<pg8::EpiOut, true>(lds, g, S, E0, wid); }
#endif
        pg8::EpiOut E{HB, out, PP, rowss};
        pg8::gemm_phase<pg8::EpiOut, true>(lds, g, S, E, wid);
    }
#undef IN
#undef SEAM
}

#ifndef N_LAUNCHES_DUMMY
#define N_LAUNCHES 1
#endif

extern "C" void kernel_launch(void* const* d_in, const int* in_sizes, int n_in, void* d_out, int out_size, void* d_ws, size_t ws_size, hipStream_t stream) {
    static int grid = 0;
    if (grid == 0) {
        if (n_in != 16 || out_size != M * DM || ws_size < WS_END) { fprintf(stderr, "kernel_launch: unexpected problem (n_in %d out %d ws %zu)\n", n_in, out_size, ws_size); grid = -1; return; }
        int dev = 0, cus = 0, per_cu = 0;
        if (hipGetDevice(&dev) != hipSuccess || hipDeviceGetAttribute(&cus, hipDeviceAttributeMultiprocessorCount, dev) != hipSuccess) { grid = -1; return; }
        if (hipFuncSetAttribute((const void*)fwd, hipFuncAttributeMaxDynamicSharedMemorySize, LDS_BYTES) != hipSuccess) { fprintf(stderr, "kernel_launch: hipFuncSetAttribute failed\n"); grid = -1; return; }
        if (hipOccupancyMaxActiveBlocksPerMultiprocessor(&per_cu, (const void*)fwd, NWAVES * 64, LDS_BYTES) != hipSuccess || per_cu < 1) { fprintf(stderr, "kernel_launch: occupancy query says %d\n", per_cu); grid = -1; return; }
        grid = cus * per_cu;
    }
    if (grid < 0) return;
    if (hipMemsetAsync((char*)d_ws + WS_BAR, 0, XCD_BAR_WORDS * 4, stream) != hipSuccess) { fprintf(stderr, "kernel_launch: memset failed\n"); return; }
    Args a{};
    for (int i = 0; i < 16; ++i) a.in[i] = (const float*)d_in[i];
    a.out = (float*)d_out; a.ws = (unsigned char*)d_ws;
#if N_LAUNCHES == 1
    a.ph_lo = 0; a.ph_hi = 5;
    void* kargs[] = {&a};
    hipError_t e = hipLaunchCooperativeKernel((const void*)fwd, dim3(grid), dim3(NWAVES * 64), kargs, LDS_BYTES, stream);
    if (e != hipSuccess) fprintf(stderr, "cooperative launch failed: %s (grid %d)\n", hipGetErrorString(e), grid);
#else
    for (int ph = 0; ph < 5; ++ph) { a.ph_lo = ph; a.ph_hi = ph + 1; hipLaunchKernelGGL(fwd, dim3(grid), dim3(NWAVES * 64), LDS_BYTES, stream, a); }
#endif
}
```

```cpp
#include <hip/hip_runtime.h>
#include <cstdio>
#include <cstdint>

#define LAS __attribute__((address_space(3)))
#define GAS __attribute__((address_space(1)))
typedef unsigned short bf16_t;
typedef short bf16x8 __attribute__((ext_vector_type(8)));
typedef short s16x4 __attribute__((ext_vector_type(4)));
typedef float f32x4 __attribute__((ext_vector_type(4)));
typedef float f32x2 __attribute__((ext_vector_type(2)));
typedef __bf16 bf16x2_t __attribute__((ext_vector_type(2)));
typedef unsigned u32x4 __attribute__((ext_vector_type(4)));
typedef unsigned u32x2 __attribute__((ext_vector_type(2)));

constexpr int M = 8192, DM = 2048, DIN = 7168, PLE = 256, SEQ = 2048;
constexpr float EPS = 1e-6f;
constexpr int NWAVES = 8;
constexpr int LDS_BYTES = 147456;
constexpr size_t MiB = 1u << 20;
constexpr size_t WS_ROWSS = 0;
constexpr size_t WS_BAR = 65536;
constexpr size_t WS_PTRS = 131072;
constexpr size_t WS_TAB = 1 * MiB;
constexpr size_t WS_WIN = 2 * MiB;
constexpr size_t WS_WOUT = 30 * MiB;
constexpr size_t WS_WG = 38 * MiB;
constexpr size_t WS_WP = 46 * MiB;
constexpr size_t WS_U = 47 * MiB;
constexpr size_t WS_MIX = WS_U;
constexpr size_t WS_PB = 79 * MiB;
constexpr size_t WS_Z = 83 * MiB;
constexpr size_t WS_HB = WS_Z;
constexpr size_t WS_PP = 195 * MiB;
constexpr size_t WS_END = 227 * MiB;

__device__ __forceinline__ unsigned cvtpk(float lo, float hi) { f32x2 v = {lo, hi}; bf16x2_t b = __builtin_convertvector(v, bf16x2_t); return __builtin_bit_cast(unsigned, b); }
__device__ __forceinline__ float bflo(unsigned u) { return __uint_as_float(u << 16); }
__device__ __forceinline__ float bfhi(unsigned u) { return __uint_as_float(u & 0xffff0000u); }
__device__ __forceinline__ int lane_id() { return (int)__builtin_amdgcn_mbcnt_hi(~0u, __builtin_amdgcn_mbcnt_lo(~0u, 0u)); }
__device__ __forceinline__ float quad_sum(float v) {
    v += __uint_as_float((unsigned)__builtin_amdgcn_ds_swizzle((int)__float_as_uint(v), 0x401F));
    const auto rr = __builtin_amdgcn_permlane32_swap(__float_as_uint(v), __float_as_uint(v), false, false);
    return __uint_as_float(rr[0]) + __uint_as_float(rr[1]);
}
__device__ __forceinline__ float wave_sum(float v) {
#pragma unroll
    for (int o = 1; o < 64; o <<= 1) v += __shfl_xor(v, o);
    return v;
}
__device__ __forceinline__ float wave_max(float v) {
#pragma unroll
    for (int o = 1; o < 64; o <<= 1) v = fmaxf(v, __shfl_xor(v, o));
    return v;
}

__device__ __forceinline__ float lg2gamma(int h) {
    return h == 0 ? -0.04580368961312479f : h == 1 ? -0.02272007650008353f : h == 2 ? -0.011315313227834146f : h == 3 ? -0.005646563141142063f :
           h == 4 ? -0.0028205190623786626f : h == 5 ? -0.0014095702546713536f : h == 6 ? -0.0007046129765893727f : -0.0003522634716290214f;
}

namespace pg8 {
constexpr int BM = 256, BK = 64, HALF = 128, HTB = HALF * BK * 2, STAGE_BYTES = 8 * HTB, NXCD = 8, WGM = 8;
__host__ __device__ __forceinline__ int lds_byte(int r, int c) { const int st = (r >> 4) * 2 + (c >> 5), rr = r & 15, cc = c & 31, ob = rr * 64 + cc * 2; return st * 1024 + (ob ^ (((ob >> 9) & 1) << 5)); }
__host__ __device__ __forceinline__ void stage_rc(int b, int& R, int& C) { const int st = b / 1024, sb = b % 1024, swz = sb ^ (((sb >> 9) & 1) << 5); R = (st >> 1) * 16 + swz / 64; C = (st & 1) * 32 + (swz % 64) / 2; }
__host__ __device__ __forceinline__ int perm32(int rho) { const int n = rho >> 4, i = rho & 15; return 8 * (i >> 2) + 4 * n + (i & 3); }

struct Unit { int pm, pn; };
struct Gemm { const bf16_t* A; const bf16_t* Bt; int M, N, K; };

struct StaticOrder {
    int nM, nN, nwg, G, c;
    __device__ void init(int M_, int N_, int G_, int c_) { nM = M_ / BM; nN = N_ / BM; nwg = nM * nN; G = G_; c = c_; }
    __device__ bool next(int i, Unit& u) const {
        const long L = (long)i * G + c; if (c < 0 || L >= nwg) return false;
        int wgid = (int)L; { const int q = nwg / NXCD, r = nwg % NXCD, xcd = wgid % NXCD, off = wgid / NXCD; wgid = (xcd < r ? xcd * (q + 1) : r * (q + 1) + (xcd - r) * q) + off; }
        const int nig = WGM * nN, gid = wgid / nig, fm = gid * WGM, gsz = (nM - fm) < WGM ? (nM - fm) : WGM;
        u.pm = fm + ((wgid % nig) % gsz); u.pn = (wgid % nig) / gsz; return true;
    }
};

template <class Epi, bool ALIGN_EPI>
__device__ __forceinline__ void gemm_phase(LAS unsigned char* lds, const Gemm g, const StaticOrder& S, const Epi& E, const int wid) {
    int lane = lane_id(); asm volatile("" : "+v"(lane));
    const int tid = wid * 64 + lane, wr = wid >> 2, wc = wid & 3, fr = lane & 15, fq = lane >> 4;
    const int K = g.K, nt = K / BK;
    unsigned voffA[2], voffB[2];
#pragma unroll
    for (int i = 0; i < 2; ++i) { int R, C; stage_rc(tid * 16 + i * 8192, R, C); const int Rb = 64 * (R >> 5) + perm32(R & 31);
        voffA[i] = (unsigned)(R * K + C) * 2u; voffB[i] = (unsigned)(Rb * K + C) * 2u; }
    const size_t kstep = (size_t)(BK * 2);
    const size_t hstep = (size_t)HALF * K * 2;
    const size_t hstepB = (size_t)32 * K * 2;
    const size_t tstep = 2 * hstep;
    const unsigned ldsw = (unsigned)wid * 1024u;
    const int aoff = lds_byte(wr * 64 + fr, fq * 8), boff = lds_byte(wc * 32 + fr, fq * 8);
#define PG8_SA(b, h) (((b) * 2 + (h)) * HTB)
#define PG8_SB(b, h) ((4 + (b) * 2 + (h)) * HTB)
#define PG8_STAGE(bufoff, gbase, voff) do { unsigned long long _gb = (unsigned long long)(gbase); asm volatile("" : "+s"(_gb)); _Pragma("unroll") for (int _i = 0; _i < 2; ++_i) \
        __builtin_amdgcn_global_load_lds((const GAS unsigned*)((const GAS char*)_gb + (voff)[_i]), (LAS unsigned*)(lds + (bufoff) + ldsw + _i * 8192), 16, 0, 0); } while (0)
#define PG8_LDA(dst, b, h) do { _Pragma("unroll") for (int m = 0; m < 4; ++m) _Pragma("unroll") for (int k = 0; k < 2; ++k) dst[m][k] = *(const LAS bf16x8*)(lds + PG8_SA(b, h) + aoff + m * 2048 + k * 1024); } while (0)
#define PG8_LDB(dst, b, h) do { _Pragma("unroll") for (int n = 0; n < 2; ++n) _Pragma("unroll") for (int k = 0; k < 2; ++k) dst[n][k] = *(const LAS bf16x8*)(lds + PG8_SB(b, h) + boff + n * 2048 + k * 1024); } while (0)
#define PG8_MMA(ai, bj, At, Bt) do { __builtin_amdgcn_s_setprio(1); _Pragma("unroll") for (int m = 0; m < 4; ++m) _Pragma("unroll") for (int n = 0; n < 2; ++n) _Pragma("unroll") for (int k = 0; k < 2; ++k) \
        acc[ai][bj][m][n] = __builtin_amdgcn_mfma_f32_16x16x32_bf16(Bt[n][k], At[m][k], acc[ai][bj][m][n], 0, 0, 0); __builtin_amdgcn_s_setprio(0); } while (0)
#define PG8_WAIT_V(n) asm volatile("s_waitcnt vmcnt(" #n ")" ::: "memory")
#define PG8_WAIT_L(n) asm volatile("s_waitcnt lgkmcnt(" #n ")" ::: "memory")
#define PG8_BAR __builtin_amdgcn_s_barrier()
#define PG8_SCHED __builtin_amdgcn_sched_barrier(0)
    Unit cur, nxt; int ui = 0;
    if (!S.next(0, cur)) return;
    f32x4 acc[2][2][4][2];
#pragma unroll
    for (int a = 0; a < 2; ++a)
#pragma unroll
        for (int b = 0; b < 2; ++b)
#pragma unroll
            for (int m = 0; m < 4; ++m)
#pragma unroll
                for (int n = 0; n < 2; ++n) acc[a][b][m][n] = (f32x4){0.f, 0.f, 0.f, 0.f};
    bf16x8 At[4][2], B0[2][2], B1[2][2];
    const char* cA = (const char*)g.A + (size_t)cur.pm * tstep; const char* cB = (const char*)g.Bt + (size_t)cur.pn * tstep;
    PG8_STAGE(PG8_SB(0, 0), cB, voffB); PG8_STAGE(PG8_SB(0, 1), cB + hstepB, voffB); PG8_STAGE(PG8_SA(0, 0), cA, voffA); PG8_STAGE(PG8_SA(0, 1), cA + hstep, voffA);
    if (wr == 1) PG8_BAR;
    PG8_WAIT_V(2); PG8_BAR;
    PG8_STAGE(PG8_SB(1, 0), cB + kstep, voffB); PG8_STAGE(PG8_SA(1, 0), cA + kstep, voffA); PG8_STAGE(PG8_SB(1, 1), cB + hstepB + kstep, voffB);
    PG8_WAIT_V(6); PG8_BAR;
    for (;;) {
        const bool has_next = S.next(ui + 1, nxt);
        const char* nA = has_next ? (const char*)g.A + (size_t)nxt.pm * tstep : cA; const char* nB = has_next ? (const char*)g.Bt + (size_t)nxt.pn * tstep : cB;
        for (int t = 0; t < nt; t += 2) {
            const bool last = (t == nt - 2);
            const char* a1 = cA + (size_t)(t + 1) * kstep;
            const char* a2 = last ? nA : cA + (size_t)(t + 2) * kstep; const char* b2 = last ? nB : cB + (size_t)(t + 2) * kstep;
            const char* a3 = a2 + kstep; const char* b3 = b2 + kstep;
            PG8_LDB(B0, 0, 0); PG8_LDB(B1, 0, 1); PG8_SCHED; PG8_LDA(At, 0, 0); PG8_STAGE(PG8_SA(1, 1), a1 + hstep, voffA);
            PG8_WAIT_V(8); PG8_WAIT_L(0); PG8_BAR; PG8_MMA(0, 0, At, B0); PG8_MMA(0, 1, At, B1); PG8_BAR; PG8_SCHED;
            PG8_LDA(At, 0, 1); PG8_STAGE(PG8_SB(0, 0), b2, voffB); PG8_STAGE(PG8_SB(0, 1), b2 + hstepB, voffB); PG8_STAGE(PG8_SA(0, 0), a2, voffA);
            PG8_WAIT_V(8); PG8_WAIT_L(0); PG8_BAR; PG8_MMA(1, 0, At, B0); PG8_MMA(1, 1, At, B1); PG8_BAR; PG8_SCHED;
            PG8_LDB(B0, 1, 0); PG8_LDB(B1, 1, 1); PG8_SCHED; PG8_LDA(At, 1, 0); PG8_STAGE(PG8_SA(0, 1), a2 + hstep, voffA);
            PG8_WAIT_V(8); PG8_WAIT_L(0); PG8_BAR; PG8_MMA(0, 0, At, B0); PG8_MMA(0, 1, At, B1); PG8_BAR; PG8_SCHED;
            PG8_LDA(At, 1, 1); PG8_STAGE(PG8_SB(1, 0), b3, voffB); PG8_STAGE(PG8_SB(1, 1), b3 + hstepB, voffB); PG8_STAGE(PG8_SA(1, 0), a3, voffA);
            PG8_WAIT_V(8); PG8_WAIT_L(0); PG8_BAR; PG8_MMA(1, 0, At, B0); PG8_MMA(1, 1, At, B1); PG8_BAR; PG8_SCHED;
        }
        if constexpr (ALIGN_EPI) { if (wr == 0) PG8_BAR; }
        { int l2 = lane_id(); asm volatile("" : "+v"(l2)); E(acc, cur, wr, wc, l2 & 15, (l2 >> 4) & 3); }
        if (!has_next) break;
#pragma unroll
        for (int a = 0; a < 2; ++a)
#pragma unroll
            for (int b = 0; b < 2; ++b)
#pragma unroll
                for (int m = 0; m < 4; ++m)
#pragma unroll
                    for (int n = 0; n < 2; ++n) acc[a][b][m][n] = (f32x4){0.f, 0.f, 0.f, 0.f};
        cur = nxt; cA = nA; cB = nB; ++ui;
        if constexpr (ALIGN_EPI) { if (wr == 1) PG8_BAR; }
    }
    PG8_WAIT_V(0);
    if constexpr (!ALIGN_EPI) { if (wr == 0) PG8_BAR; }
    PG8_BAR;
#undef PG8_SA
#undef PG8_SB
#undef PG8_STAGE
#undef PG8_LDA
#undef PG8_LDB
#undef PG8_MMA
#undef PG8_WAIT_V
#undef PG8_WAIT_L
#undef PG8_BAR
#undef PG8_SCHED
}

typedef f32x4 Acc[2][2][4][2];

__device__ __forceinline__ u32x4 pack8(const float (&v)[8]) { u32x4 w; w.x = cvtpk(v[0], v[1]); w.y = cvtpk(v[2], v[3]); w.z = cvtpk(v[4], v[5]); w.w = cvtpk(v[6], v[7]); return w; }

struct EpiZ {
    bf16_t* Z; const float* tab; const float* qn; const float* kn;
    template <int TYPE> __device__ __forceinline__ void run(const Acc& acc, const Unit& u, int wr, int wc, int fr, int fq) const {
        asm volatile("" : "+v"(fr), "+v"(fq));
        const int colbase = u.pn * 256 + wc * 64 + 8 * fq;
        float g[2][8];
        if (TYPE == 4 || TYPE == 5) { const float* gp = (TYPE == 4) ? qn : kn; const float sc = (TYPE == 4) ? 0.18033688011112042f : 1.0f;
#pragma unroll
            for (int bj = 0; bj < 2; ++bj)
#pragma unroll
                for (int j = 0; j < 8; ++j) g[bj][j] = gp[32 * bj + 8 * fq + j] * sc; }
#pragma unroll
        for (int ai = 0; ai < 2; ++ai)
#pragma unroll
            for (int m = 0; m < 4; ++m) {
                const int row = u.pm * 256 + ai * 128 + wr * 64 + m * 16 + fr;
                float v[2][8];
#pragma unroll
                for (int bj = 0; bj < 2; ++bj)
#pragma unroll
                    for (int n = 0; n < 2; ++n)
#pragma unroll
                        for (int i = 0; i < 4; ++i) v[bj][4 * n + i] = acc[ai][bj][m][n][i];
                if (TYPE == 0 || TYPE == 1) {
                    const int pos = row & (SEQ - 1);
                    const f32x4* tp = (const f32x4*)(tab + ((size_t)pos * 32 + 8 * fq) * 2);
                    const float lgp = lg2gamma(((u.pn & 1) << 2) + wc) * (float)pos;
                    const float sc = (TYPE == 1) ? 0.125f * __builtin_amdgcn_exp2f(-lgp) : __builtin_amdgcn_exp2f(lgp);
#pragma unroll
                    for (int jj = 0; jj < 4; ++jj) { const f32x4 cs = tp[jj];
                        { const float t1 = v[0][2 * jj], t2 = v[1][2 * jj]; v[0][2 * jj] = (t1 * cs.x - t2 * cs.y) * sc; v[1][2 * jj] = (t1 * cs.y + t2 * cs.x) * sc; }
                        { const float t1 = v[0][2 * jj + 1], t2 = v[1][2 * jj + 1]; v[0][2 * jj + 1] = (t1 * cs.z - t2 * cs.w) * sc; v[1][2 * jj + 1] = (t1 * cs.w + t2 * cs.z) * sc; } }
                }
                if (TYPE == 3) {
#pragma unroll
                    for (int bj = 0; bj < 2; ++bj)
#pragma unroll
                        for (int j = 0; j < 8; ++j) { const float x = v[bj][j]; v[bj][j] = x * __builtin_amdgcn_rcpf(1.0f + __builtin_amdgcn_exp2f(-1.4426950408889634f * x)); }
                }
                if (TYPE == 4 || TYPE == 5) {
                    float ss = 0.f;
#pragma unroll
                    for (int bj = 0; bj < 2; ++bj)
#pragma unroll
                        for (int j = 0; j < 8; ++j) ss += v[bj][j] * v[bj][j];
                    ss = quad_sum(ss);
                    const float r = rsqrtf(ss * (1.0f / 64.0f) + EPS);
#pragma unroll
                    for (int bj = 0; bj < 2; ++bj)
#pragma unroll
                        for (int j = 0; j < 8; ++j) v[bj][j] = v[bj][j] * r * g[bj][j];
                }
                bf16_t* rowp = Z + (size_t)row * DIN + colbase;
                *(u32x4*)(rowp) = pack8(v[0]); *(u32x4*)(rowp + 32) = pack8(v[1]);
            }
    }
    __device__ __forceinline__ void operator()(const Acc& acc, const Unit& u, int wr, int wc, int fr, int fq) const {
        const int pn = u.pn;
        if (pn < 2) run<0>(acc, u, wr, wc, fr, fq);
        else if (pn < 4) run<1>(acc, u, wr, wc, fr, fq);
        else if (pn < 8) run<2>(acc, u, wr, wc, fr, fq);
        else if (pn < 12) run<3>(acc, u, wr, wc, fr, fq);
        else if (pn < 16) run<4>(acc, u, wr, wc, fr, fq);
        else if (pn < 20) run<5>(acc, u, wr, wc, fr, fq);
        else if (pn < 24) run<2>(acc, u, wr, wc, fr, fq);
        else run<3>(acc, u, wr, wc, fr, fq);
    }
};
struct EpiBf {
    bf16_t* O; int ldc;
    __device__ __forceinline__ void operator()(const Acc& acc, const Unit& u, int wr, int wc, int fr, int fq) const {
        asm volatile("" : "+v"(fr), "+v"(fq));
        const int colbase = u.pn * 256 + wc * 64 + 8 * fq;
#pragma unroll
        for (int ai = 0; ai < 2; ++ai)
#pragma unroll
            for (int m = 0; m < 4; ++m) {
                const int row = u.pm * 256 + ai * 128 + wr * 64 + m * 16 + fr;
#pragma unroll
                for (int bj = 0; bj < 2; ++bj) { float v[8];
#pragma unroll
                    for (int n = 0; n < 2; ++n)
#pragma unroll
                        for (int i = 0; i < 4; ++i) v[4 * n + i] = acc[ai][bj][m][n][i];
                    *(u32x4*)(O + (size_t)row * ldc + colbase + 32 * bj) = pack8(v); }
            }
    }
};
struct EpiH {
    const float* x; float* out; bf16_t* HB; float* rowss;
    __device__ __forceinline__ void operator()(const Acc& acc, const Unit& u, int wr, int wc, int fr, int fq) const {
        asm volatile("" : "+v"(fr), "+v"(fq));
        const int colbase = u.pn * 256 + wc * 64 + 8 * fq;
#pragma unroll
        for (int ai = 0; ai < 2; ++ai) {
            f32x4 xv[4][2][2];
#pragma unroll
            for (int m = 0; m < 4; ++m) { const size_t off = (size_t)(u.pm * 256 + ai * 128 + wr * 64 + m * 16 + fr) * DM + colbase;
#pragma unroll
                for (int bj = 0; bj < 2; ++bj) { xv[m][bj][0] = __builtin_nontemporal_load((const f32x4*)(x + off + 32 * bj)); xv[m][bj][1] = __builtin_nontemporal_load((const f32x4*)(x + off + 32 * bj + 4)); } }
#pragma unroll
            for (int m = 0; m < 4; ++m) {
                const int row = u.pm * 256 + ai * 128 + wr * 64 + m * 16 + fr;
                float ss = 0.f;
#pragma unroll
                for (int bj = 0; bj < 2; ++bj) {
                    const size_t off = (size_t)row * DM + colbase + 32 * bj;
                    const f32x4 h0 = xv[m][bj][0] + acc[ai][bj][m][0], h1 = xv[m][bj][1] + acc[ai][bj][m][1];
                    u32x4 w; w.x = cvtpk(h0.x, h0.y); w.y = cvtpk(h0.z, h0.w); w.z = cvtpk(h1.x, h1.y); w.w = cvtpk(h1.z, h1.w);
                    *(u32x4*)(HB + off) = w;
                    ss += (h0.x * h0.x + h0.y * h0.y) + (h0.z * h0.z + h0.w * h0.w) + (h1.x * h1.x + h1.y * h1.y) + (h1.z * h1.z + h1.w * h1.w);
                }
                ss = quad_sum(ss);
                if (fq == 0) atomicAdd(rowss + row, ss);
            }
        }
    }
};
struct EpiOut {
    const bf16_t* hin; float* out; const bf16_t* PP; const float* rowss;
    __device__ __forceinline__ void operator()(const Acc& acc, const Unit& u, int wr, int wc, int fr, int fq) const {
        asm volatile("" : "+v"(fr), "+v"(fq));
        const int colbase = u.pn * 256 + wc * 64 + 8 * fq;
#pragma unroll
        for (int ai = 0; ai < 2; ++ai) {
            f32x4 hv[4][2][2]; u32x4 pw[4][2]; float rsv[4];
#pragma unroll
            for (int m = 0; m < 4; ++m) { const int row = u.pm * 256 + ai * 128 + wr * 64 + m * 16 + fr; const size_t off = (size_t)row * DM + colbase;
                rsv[m] = rowss[row];
#pragma unroll
                for (int bj = 0; bj < 2; ++bj) { const u32x4 hw = __builtin_nontemporal_load((const u32x4*)(hin + off + 32 * bj));
                    hv[m][bj][0] = (f32x4){bflo(hw.x), bfhi(hw.x), bflo(hw.y), bfhi(hw.y)}; hv[m][bj][1] = (f32x4){bflo(hw.z), bfhi(hw.z), bflo(hw.w), bfhi(hw.w)};
                    pw[m][bj] = __builtin_nontemporal_load((const u32x4*)(PP + off + 32 * bj)); } }
#pragma unroll
            for (int m = 0; m < 4; ++m) {
                const int row = u.pm * 256 + ai * 128 + wr * 64 + m * 16 + fr;
                const float rs = rsqrtf(rsv[m] * (1.0f / DM) + EPS) * -1.4426950408889634f;
#pragma unroll
                for (int bj = 0; bj < 2; ++bj) {
                    const size_t off = (size_t)row * DM + colbase + 32 * bj;
                    f32x4 h0 = hv[m][bj][0], h1 = hv[m][bj][1];
                    const u32x4 p4 = pw[m][bj];
                    const f32x4 a0 = acc[ai][bj][m][0], a1 = acc[ai][bj][m][1];
                    h0.x += bflo(p4.x) * __builtin_amdgcn_rcpf(1.0f + __builtin_amdgcn_exp2f(a0.x * rs));
                    h0.y += bfhi(p4.x) * __builtin_amdgcn_rcpf(1.0f + __builtin_amdgcn_exp2f(a0.y * rs));
                    h0.z += bflo(p4.y) * __builtin_amdgcn_rcpf(1.0f + __builtin_amdgcn_exp2f(a0.z * rs));
                    h0.w += bfhi(p4.y) * __builtin_amdgcn_rcpf(1.0f + __builtin_amdgcn_exp2f(a0.w * rs));
                    h1.x += bflo(p4.z) * __builtin_amdgcn_rcpf(1.0f + __builtin_amdgcn_exp2f(a1.x * rs));
                    h1.y += bfhi(p4.z) * __builtin_amdgcn_rcpf(1.0f + __builtin_amdgcn_exp2f(a1.y * rs));
                    h1.z += bflo(p4.w) * __builtin_amdgcn_rcpf(1.0f + __builtin_amdgcn_exp2f(a1.z * rs));
                    h1.w += bfhi(p4.w) * __builtin_amdgcn_rcpf(1.0f + __builtin_amdgcn_exp2f(a1.w * rs));
                    *(f32x4*)(out + off) = h0; *(f32x4*)(out + off + 4) = h1;
                }
            }
        }
    }
};
}

constexpr int ATT_TILE = 2 * 8192 + 64 * 288;
constexpr int ATT_BUF = 2 * ATT_TILE;
template <bool DIFF>
__device__ __forceinline__ void attn_item(LAS unsigned char* lds, const bf16_t* Z, bf16_t* MIX, int b, int h, int t, float lam, float shift, const float* gain, int tid, int wid, int lane) {
    constexpr int NC = DIFF ? 2 : 1;
    lane = lane_id(); asm volatile("" : "+v"(lane)); tid = wid * 64 + lane;
    const int q16 = lane & 15, quad = lane >> 4;
    const int row0 = b * SEQ + 128 * t + 16 * wid;
    const int cq = 2 * t + (wid >> 2), nkt = 2 * t + 2;
    const int qcol = DIFF ? (3072 + 128 * h) : (64 * h);
    const int kcol = DIFF ? (4096 + 128 * h) : (512 + 64 * h);
    const int vcol = DIFF ? (5120 + 128 * h) : (1024 + 128 * h);
    const int gcol = DIFF ? (6144 + 128 * h) : (2048 + 128 * h);
    const float lg = lg2gamma(h);
    bf16x8 qf[NC][2];
    { const bf16_t* qrow = Z + (size_t)(row0 + q16) * DIN + qcol;
#pragma unroll
      for (int c = 0; c < NC; ++c)
#pragma unroll
          for (int ds = 0; ds < 2; ++ds) qf[c][ds] = __builtin_nontemporal_load((const bf16x8*)(qrow + 64 * c + 32 * ds + 8 * quad)); }
    f32x4 O[NC][8]; float l[NC];
#pragma unroll
    for (int c = 0; c < NC; ++c) { l[c] = 0.f;
#pragma unroll
        for (int eb = 0; eb < 8; ++eb) O[c][eb] = (f32x4){0.f, 0.f, 0.f, 0.f}; }
    const char* kbase = (const char*)(Z + (size_t)(b * SEQ) * DIN + kcol);
    const char* vbase = (const char*)(Z + (size_t)(b * SEQ) * DIN + vcol);
    const unsigned krow = (unsigned)(8 * wid + (lane >> 3));
    const unsigned kso = (krow * DIN + 8u * ((unsigned)(lane & 7) ^ (krow & 7u))) * 2u;
    const unsigned vrow = (unsigned)(4 * wid + (lane >> 4));
    const unsigned vso = (vrow * DIN + 8u * (2u * ((((unsigned)lane & 15u) >> 1) ^ (vrow & 7u)) + ((unsigned)lane & 1u))) * 2u;
    constexpr int ATT_RING = 32768;
#define ATT_DMA(kt, bi) do { const size_t _o = (size_t)(kt) * (64 * DIN * 2); \
        unsigned long long _kb = (unsigned long long)(kbase + _o); asm volatile("" : "+s"(_kb)); unsigned long long _vb = (unsigned long long)(vbase + _o); asm volatile("" : "+s"(_vb)); \
        unsigned long long _vb2 = _vb + 32 * DIN * 2; asm volatile("" : "+s"(_vb2)); \
        LAS unsigned char* _bp = lds + (bi) * ATT_RING + 1024 * wid; \
        _Pragma("unroll") for (int c = 0; c < NC; ++c) __builtin_amdgcn_global_load_lds((const GAS unsigned*)((const GAS char*)_kb + kso + 128 * c), (LAS unsigned*)(_bp + c * 8192), 16, 0, 0); \
        __builtin_amdgcn_global_load_lds((const GAS unsigned*)((const GAS char*)_vb + vso), (LAS unsigned*)(_bp + 16384), 16, 0, 0); \
        __builtin_amdgcn_global_load_lds((const GAS unsigned*)((const GAS char*)_vb2 + vso), (LAS unsigned*)(_bp + 16384 + 8192), 16, 0, 0); } while (0)
#define ATT_WAITBAR_ALL() asm volatile("s_waitcnt vmcnt(0) lgkmcnt(0)\n\ts_barrier" ::: "memory")
#define ATT_WAITBAR_ONE() do { if (DIFF) asm volatile("s_waitcnt vmcnt(4) lgkmcnt(0)\n\ts_barrier" ::: "memory"); else asm volatile("s_waitcnt vmcnt(3) lgkmcnt(0)\n\ts_barrier" ::: "memory"); } while (0)
    asm volatile("s_waitcnt lgkmcnt(0)\n\ts_barrier" ::: "memory");
    ATT_DMA(0, 0); ATT_DMA(1, 1);
    ATT_WAITBAR_ONE();
    const unsigned kfo = (unsigned)(q16 * 128), ksw = (unsigned)(q16 & 7);
    const unsigned vrr = (unsigned)(4 * quad + (q16 >> 2)), vx32 = (vrr & 7u) * 32u, vb0 = 16384u + vrr * 256u + 8u * (unsigned)(q16 & 3);
    const float iq = (float)(128 * t + 16 * wid + q16);
    int bcur = 0;
    for (int kt = 0; kt < nkt; ++kt) {
        const int bnx = (bcur == 2) ? 0 : bcur + 1, bn2 = (bnx == 2) ? 0 : bnx + 1;
        const bool more2 = (kt + 2 < nkt);
        if (more2) ATT_DMA(kt + 2, bn2);
        if (kt <= cq) {
            LAS unsigned char* bp = lds + bcur * ATT_RING;
            const float msk = 0.f;
            const float sinit = DIFF ? (msk - shift) : 0.f;
            bf16x8 kfA[8], kfB[8]; s16x4 vAl[8], vAh[8], vBl[8], vBh[8];
            f32x4 s0[4], s1[4];
            bf16x8 P[NC][2];
            const unsigned bpa = (unsigned)(size_t)bp;
#define ATT_KREAD(dst, c) do { _Pragma("unroll") for (int kb = 0; kb < 4; ++kb) _Pragma("unroll") for (int ds = 0; ds < 2; ++ds) \
                dst[kb * 2 + ds] = *(const LAS bf16x8*)(bp + (c) * 8192 + kb * 2048 + kfo + (((unsigned)(4 * ds + quad) ^ ksw) * 16)); } while (0)
#define ATT_VISSUE(lo_, hi_, eb0) do { _Pragma("unroll") for (int e = 0; e < 4; ++e) { const unsigned _a = bpa + vb0 + (((unsigned)((eb0) + e) * 32u) ^ vx32); \
                asm volatile("ds_read_b64_tr_b16 %0, %1 offset:0"     : "=&v"(lo_[e * 2 + 0]) : "v"(_a)); \
                asm volatile("ds_read_b64_tr_b16 %0, %1 offset:4096"  : "=&v"(hi_[e * 2 + 0]) : "v"(_a)); \
                asm volatile("ds_read_b64_tr_b16 %0, %1 offset:8192"  : "=&v"(lo_[e * 2 + 1]) : "v"(_a)); \
                asm volatile("ds_read_b64_tr_b16 %0, %1 offset:12288" : "=&v"(hi_[e * 2 + 1]) : "v"(_a)); } } while (0)
#define ATT_W4(N_, lo_, hi_, e_) asm volatile("s_waitcnt lgkmcnt(" #N_ ")" : "+v"(lo_[2 * (e_)]), "+v"(hi_[2 * (e_)]), "+v"(lo_[2 * (e_) + 1]), "+v"(hi_[2 * (e_) + 1]))
#define ATT_VWAIT15(lo_, hi_) asm volatile("s_waitcnt lgkmcnt(15)" : "+v"(lo_[0]), "+v"(lo_[1]), "+v"(lo_[2]), "+v"(lo_[3]), "+v"(lo_[4]), "+v"(lo_[5]), "+v"(lo_[6]), "+v"(lo_[7]), \
                "+v"(hi_[0]), "+v"(hi_[1]), "+v"(hi_[2]), "+v"(hi_[3]), "+v"(hi_[4]), "+v"(hi_[5]), "+v"(hi_[6]), "+v"(hi_[7]))
#define ATT_VWAIT(lo_, hi_) asm volatile("s_waitcnt lgkmcnt(0)" : "+v"(lo_[0]), "+v"(lo_[1]), "+v"(lo_[2]), "+v"(lo_[3]), "+v"(lo_[4]), "+v"(lo_[5]), "+v"(lo_[6]), "+v"(lo_[7]), \
                "+v"(hi_[0]), "+v"(hi_[1]), "+v"(hi_[2]), "+v"(hi_[3]), "+v"(hi_[4]), "+v"(hi_[5]), "+v"(hi_[6]), "+v"(hi_[7]))
#define ATT_SMMA(sv, kf, c) do { _Pragma("unroll") for (int kb = 0; kb < 4; ++kb) { sv[kb] = (f32x4){sinit, sinit, sinit, sinit}; _Pragma("unroll") for (int ds = 0; ds < 2; ++ds) \
                sv[kb] = __builtin_amdgcn_mfma_f32_16x16x32_bf16(kf[kb * 2 + ds], qf[c][ds], sv[kb], 0, 0, 0); } } while (0)
#define ATT_SOFT(sv, c) do { _Pragma("unroll") for (int kb = 0; kb < 4; ++kb) _Pragma("unroll") for (int i = 0; i < 4; ++i) { \
                if (DIFF) { const float p = __builtin_amdgcn_exp2f(sv[kb][i]); sv[kb][i] = p; l[c] += p; } \
                else if (kt == cq) { const float dj = (float)(64 * kt + 16 * kb + 4 * quad + i) - iq; if (dj > 0.f) sv[kb][i] = sv[kb][i] * __builtin_amdgcn_exp2f(2.0f * lg * dj); } } \
                _Pragma("unroll") for (int ks = 0; ks < 2; ++ks) { u32x4 w; w.x = cvtpk(sv[2 * ks][0], sv[2 * ks][1]); w.y = cvtpk(sv[2 * ks][2], sv[2 * ks][3]); w.z = cvtpk(sv[2 * ks + 1][0], sv[2 * ks + 1][1]); w.w = cvtpk(sv[2 * ks + 1][2], sv[2 * ks + 1][3]); \
                    P[c][ks] = __builtin_bit_cast(bf16x8, w); } } while (0)
#define ATT_PV(c, lo_, hi_, eb0) do { _Pragma("unroll") for (int e = 0; e < 4; ++e) _Pragma("unroll") for (int ks = 0; ks < 2; ++ks) \
                O[c][(eb0) + e] = __builtin_amdgcn_mfma_f32_16x16x32_bf16(__builtin_shufflevector(lo_[e * 2 + ks], hi_[e * 2 + ks], 0, 1, 2, 3, 4, 5, 6, 7), P[c][ks], O[c][(eb0) + e], 0, 0, 0); } while (0)
#define ATT_PV1(c, lo_, hi_, eb0, e) do { _Pragma("unroll") for (int ks = 0; ks < 2; ++ks) \
                O[c][(eb0) + (e)] = __builtin_amdgcn_mfma_f32_16x16x32_bf16(__builtin_shufflevector(lo_[(e) * 2 + ks], hi_[(e) * 2 + ks], 0, 1, 2, 3, 4, 5, 6, 7), P[c][ks], O[c][(eb0) + (e)], 0, 0, 0); } while (0)
#define ATT_PVW(c, lo_, hi_, eb0) do { ATT_W4(12, lo_, hi_, 0); ATT_PV1(c, lo_, hi_, eb0, 0); ATT_W4(8, lo_, hi_, 1); ATT_PV1(c, lo_, hi_, eb0, 1); \
                ATT_W4(4, lo_, hi_, 2); ATT_PV1(c, lo_, hi_, eb0, 2); ATT_W4(0, lo_, hi_, 3); ATT_PV1(c, lo_, hi_, eb0, 3); } while (0)
#define ATT_SB __builtin_amdgcn_sched_barrier(0)
            ATT_KREAD(kfA, 0); ATT_SB;
            if (DIFF) { ATT_KREAD(kfB, NC - 1); ATT_SMMA(s0, kfA, 0); ATT_SB;
                        ATT_VISSUE(vAl, vAh, 0); ATT_SMMA(s1, kfB, NC - 1); ATT_SOFT(s0, 0); ATT_SB;
                        ATT_SOFT(s1, NC - 1); ATT_PVW(0, vAl, vAh, 0); ATT_SB;
                        ATT_VISSUE(vBl, vBh, 4); ATT_PV(NC - 1, vAl, vAh, 0); ATT_SB;
                        ATT_PVW(0, vBl, vBh, 4); ATT_PV(NC - 1, vBl, vBh, 4); ATT_SB; }
            else      { ATT_VISSUE(vAl, vAh, 0); ATT_SMMA(s0, kfA, 0); ATT_SB;
                        ATT_VISSUE(vBl, vBh, 4); ATT_SOFT(s0, 0); ATT_SB;
                        ATT_VWAIT15(vAl, vAh); ATT_PV(0, vAl, vAh, 0); ATT_PVW(0, vBl, vBh, 4); ATT_SB; }
#undef ATT_KREAD
#undef ATT_VISSUE
#undef ATT_VWAIT
#undef ATT_VWAIT15
#undef ATT_W4
#undef ATT_PV1
#undef ATT_PVW
#undef ATT_SMMA
#undef ATT_SOFT
#undef ATT_PV
#undef ATT_SB
        }
        if (kt + 1 < nkt) { if (more2) ATT_WAITBAR_ONE(); else ATT_WAITBAR_ALL(); }
        bcur = bnx;
    }
#undef ATT_DMA
#undef ATT_WAITBAR_ALL
#undef ATT_WAITBAR_ONE
    float inv0 = 1.f, inv1 = 0.f;
    if (DIFF) {
#pragma unroll
        for (int c = 0; c < NC; ++c) l[c] = quad_sum(l[c]);
        inv0 = 1.0f / l[0]; inv1 = lam / l[NC - 1];
    }
    float ss = 0.f;
#pragma unroll
    for (int eb = 0; eb < 8; ++eb)
#pragma unroll
        for (int i = 0; i < 4; ++i) { float v = O[0][eb][i] * inv0; if (DIFF) v -= O[NC - 1][eb][i] * inv1; O[0][eb][i] = v; ss += v * v; }
    ss = quad_sum(ss);
    const float r = rsqrtf(ss * (1.0f / 128.0f) + EPS) * (DIFF ? 0.8f : 1.0f);
    const int row = row0 + q16;
    const bf16_t* gp = Z + (size_t)row * DIN + gcol + 4 * quad;
    bf16_t* op = MIX + (size_t)row * DM + (DIFF ? 1024 : 0) + 128 * h + 4 * quad;
#pragma unroll
    for (int eb = 0; eb < 8; ++eb) {
        const u32x2 gw = *(const u32x2*)(gp + 16 * eb);
        const f32x4 gn = *(const f32x4*)(gain + 16 * eb + 4 * quad);
        u32x2 w; w.x = cvtpk(O[0][eb][0] * r * gn.x * bflo(gw.x), O[0][eb][1] * r * gn.y * bfhi(gw.x));
        w.y = cvtpk(O[0][eb][2] * r * gn.z * bflo(gw.y), O[0][eb][3] * r * gn.w * bfhi(gw.y));
        *(u32x2*)(op + 16 * eb) = w;
    }
}

__device__ __forceinline__ void ret_pair(LAS unsigned char* lds, const bf16_t* Z, bf16_t* MIX, int b, int h, int tA, int tB, const float* gain, int wid) {
    int lane = lane_id(); asm volatile("" : "+v"(lane));
    const int q16 = lane & 15, quad = lane >> 4;
    const int rowA0 = b * SEQ + 128 * tA + 16 * wid, rowB0 = b * SEQ + 128 * tB + 16 * wid;
    const int cqA = 2 * tA + (wid >> 2), cqB = 2 * tB + (wid >> 2), nkt = 2 * tA + 2;
    const int qcol = 64 * h, kcol = 512 + 64 * h, vcol = 1024 + 128 * h, gcol = 2048 + 128 * h;
    const float lg = lg2gamma(h);
    bf16x8 qfA[2], qfB[2];
    { const bf16_t* qa = Z + (size_t)(rowA0 + q16) * DIN + qcol; const bf16_t* qb = Z + (size_t)(rowB0 + q16) * DIN + qcol;
#pragma unroll
      for (int ds = 0; ds < 2; ++ds) { qfA[ds] = __builtin_nontemporal_load((const bf16x8*)(qa + 32 * ds + 8 * quad)); qfB[ds] = __builtin_nontemporal_load((const bf16x8*)(qb + 32 * ds + 8 * quad)); } }
    f32x4 OA[8], OB[8];
#pragma unroll
    for (int eb = 0; eb < 8; ++eb) { OA[eb] = (f32x4){0.f, 0.f, 0.f, 0.f}; OB[eb] = OA[eb]; }
    const char* kbase = (const char*)(Z + (size_t)(b * SEQ) * DIN + kcol);
    const char* vbase = (const char*)(Z + (size_t)(b * SEQ) * DIN + vcol);
    const unsigned krow = (unsigned)(8 * wid + (lane >> 3));
    const unsigned kso = (krow * DIN + 8u * ((unsigned)(lane & 7) ^ (krow & 7u))) * 2u;
    const unsigned vrow = (unsigned)(4 * wid + (lane >> 4));
    const unsigned vso = (vrow * DIN + 8u * (2u * ((((unsigned)lane & 15u) >> 1) ^ (vrow & 7u)) + ((unsigned)lane & 1u))) * 2u;
    constexpr int RING = 32768;
#define RP_DMA(kt, bi) do { const size_t _o = (size_t)(kt) * (64 * DIN * 2); \
        unsigned long long _kb = (unsigned long long)(kbase + _o); asm volatile("" : "+s"(_kb)); unsigned long long _vb = (unsigned long long)(vbase + _o); asm volatile("" : "+s"(_vb)); \
        unsigned long long _vb2 = _vb + 32 * DIN * 2; asm volatile("" : "+s"(_vb2)); \
        LAS unsigned char* _bp = lds + (bi) * RING + 1024 * wid; \
        __builtin_amdgcn_global_load_lds((const GAS unsigned*)((const GAS char*)_kb + kso), (LAS unsigned*)(_bp), 16, 0, 0); \
        __builtin_amdgcn_global_load_lds((const GAS unsigned*)((const GAS char*)_vb + vso), (LAS unsigned*)(_bp + 16384), 16, 0, 0); \
        __builtin_amdgcn_global_load_lds((const GAS unsigned*)((const GAS char*)_vb2 + vso), (LAS unsigned*)(_bp + 16384 + 8192), 16, 0, 0); } while (0)
    asm volatile("s_waitcnt lgkmcnt(0)\n\ts_barrier" ::: "memory");
    RP_DMA(0, 0); RP_DMA(1, 1);
    asm volatile("s_waitcnt vmcnt(3) lgkmcnt(0)\n\ts_barrier" ::: "memory");
    const unsigned kfo = (unsigned)(q16 * 128), ksw = (unsigned)(q16 & 7);
    const unsigned vrr = (unsigned)(4 * quad + (q16 >> 2)), vx32 = (vrr & 7u) * 32u, vb0 = 16384u + vrr * 256u + 8u * (unsigned)(q16 & 3);
    const float iqA = (float)(128 * tA + 16 * wid + q16), iqB = (float)(128 * tB + 16 * wid + q16);
#define RP_VISSUE(lo_, hi_, eb0) do { _Pragma("unroll") for (int e = 0; e < 2; ++e) { const unsigned _a = bpa + vb0 + (((unsigned)((eb0) + e) * 32u) ^ vx32); \
                asm volatile("ds_read_b64_tr_b16 %0, %1 offset:0"     : "=&v"(lo_[e * 2 + 0]) : "v"(_a)); \
                asm volatile("ds_read_b64_tr_b16 %0, %1 offset:4096"  : "=&v"(hi_[e * 2 + 0]) : "v"(_a)); \
                asm volatile("ds_read_b64_tr_b16 %0, %1 offset:8192"  : "=&v"(lo_[e * 2 + 1]) : "v"(_a)); \
                asm volatile("ds_read_b64_tr_b16 %0, %1 offset:12288" : "=&v"(hi_[e * 2 + 1]) : "v"(_a)); } } while (0)
#define RP_VWAIT(N_, lo_, hi_) asm volatile("s_waitcnt lgkmcnt(" #N_ ")" : "+v"(lo_[0]), "+v"(lo_[1]), "+v"(lo_[2]), "+v"(lo_[3]), "+v"(hi_[0]), "+v"(hi_[1]), "+v"(hi_[2]), "+v"(hi_[3]))
#define RP_SMMA(sv, qf_) do { _Pragma("unroll") for (int kb = 0; kb < 4; ++kb) { sv[kb] = (f32x4){0.f, 0.f, 0.f, 0.f}; _Pragma("unroll") for (int ds = 0; ds < 2; ++ds) \
                sv[kb] = __builtin_amdgcn_mfma_f32_16x16x32_bf16(kf[kb * 2 + ds], qf_[ds], sv[kb], 0, 0, 0); } } while (0)
#define RP_SOFT(sv, PP_, cq_, iq_) do { if (kt == (cq_)) { _Pragma("unroll") for (int kb = 0; kb < 4; ++kb) _Pragma("unroll") for (int i = 0; i < 4; ++i) { \
                const float dj = (float)(64 * kt + 16 * kb + 4 * quad + i) - (iq_); if (dj > 0.f) sv[kb][i] = sv[kb][i] * __builtin_amdgcn_exp2f(2.0f * lg * dj); } } \
                _Pragma("unroll") for (int ks = 0; ks < 2; ++ks) { u32x4 w; w.x = cvtpk(sv[2 * ks][0], sv[2 * ks][1]); w.y = cvtpk(sv[2 * ks][2], sv[2 * ks][3]); w.z = cvtpk(sv[2 * ks + 1][0], sv[2 * ks + 1][1]); w.w = cvtpk(sv[2 * ks + 1][2], sv[2 * ks + 1][3]); \
                    PP_[ks] = __builtin_bit_cast(bf16x8, w); } } while (0)
#define RP_PV(OO_, PP_, lo_, hi_, eb0) do { _Pragma("unroll") for (int e = 0; e < 2; ++e) _Pragma("unroll") for (int ks = 0; ks < 2; ++ks) \
                OO_[(eb0) + e] = __builtin_amdgcn_mfma_f32_16x16x32_bf16(__builtin_shufflevector(lo_[e * 2 + ks], hi_[e * 2 + ks], 0, 1, 2, 3, 4, 5, 6, 7), PP_[ks], OO_[(eb0) + e], 0, 0, 0); } while (0)
#define RP_SB ((void)0)
#define RP_BODY(WITHB) do { LAS unsigned char* bp = lds + bcur * RING; const unsigned bpa = (unsigned)(size_t)bp; \
            bf16x8 PA[2], PB[2]; s16x4 xl[4], xh[4]; \
            { bf16x8 kf[8]; f32x4 sA[4]; \
              _Pragma("unroll") for (int kb = 0; kb < 4; ++kb) _Pragma("unroll") for (int ds = 0; ds < 2; ++ds) \
                kf[kb * 2 + ds] = *(const LAS bf16x8*)(bp + kb * 2048 + kfo + (((unsigned)(4 * ds + quad) ^ ksw) * 16)); \
              RP_SB; \
              RP_SMMA(sA, qfA); RP_SB; \
              RP_SOFT(sA, PA, cqA, iqA); if (WITHB) RP_SMMA(sA, qfB); RP_SB; \
              RP_VISSUE(xl, xh, 0); if (WITHB) RP_SOFT(sA, PB, cqB, iqB); RP_SB; } \
            RP_VWAIT(0, xl, xh); RP_PV(OA, PA, xl, xh, 0); if (WITHB) RP_PV(OB, PB, xl, xh, 0); RP_SB; \
            RP_VISSUE(xl, xh, 2); RP_VWAIT(0, xl, xh); RP_PV(OA, PA, xl, xh, 2); if (WITHB) RP_PV(OB, PB, xl, xh, 2); RP_SB; \
            RP_VISSUE(xl, xh, 4); RP_VWAIT(0, xl, xh); RP_PV(OA, PA, xl, xh, 4); if (WITHB) RP_PV(OB, PB, xl, xh, 4); RP_SB; \
            RP_VISSUE(xl, xh, 6); RP_VWAIT(0, xl, xh); RP_PV(OA, PA, xl, xh, 6); if (WITHB) RP_PV(OB, PB, xl, xh, 6); RP_SB; } while (0)
    int bcur = 0;
    for (int kt = 0; kt < nkt; ++kt) {
        const int bnx = (bcur == 2) ? 0 : bcur + 1, bn2 = (bnx == 2) ? 0 : bnx + 1;
        const bool more2 = (kt + 2 < nkt);
        if (more2) RP_DMA(kt + 2, bn2);
        if (kt <= cqA) {
            if (kt <= cqB) RP_BODY(true); else RP_BODY(false);
        }
        if (kt + 1 < nkt) { if (more2) asm volatile("s_waitcnt vmcnt(3) lgkmcnt(0)\n\ts_barrier" ::: "memory"); else asm volatile("s_waitcnt vmcnt(0) lgkmcnt(0)\n\ts_barrier" ::: "memory"); }
        bcur = bnx;
    }
#undef RP_DMA
#undef RP_VISSUE
#undef RP_VWAIT
#undef RP_SMMA
#undef RP_SOFT
#undef RP_PV
#undef RP_SB
#undef RP_BODY
    int lf = lane_id(); asm volatile("" : "+v"(lf)); const int q16f = lf & 15, quadf = (lf >> 4) & 3;
#pragma unroll
    for (int which = 0; which < 2; ++which) {
        f32x4 (&O)[8] = which ? OB : OA;
        float ss = 0.f;
#pragma unroll
        for (int eb = 0; eb < 8; ++eb)
#pragma unroll
            for (int i = 0; i < 4; ++i) ss += O[eb][i] * O[eb][i];
        ss = quad_sum(ss);
        const float r = rsqrtf(ss * (1.0f / 128.0f) + EPS);
        const int row = (which ? rowB0 : rowA0) + q16f;
        const bf16_t* gp = Z + (size_t)row * DIN + gcol + 4 * quadf;
        bf16_t* op = MIX + (size_t)row * DM + 128 * h + 4 * quadf;
#pragma unroll
        for (int eb = 0; eb < 8; ++eb) {
            const u32x2 gw = *(const u32x2*)(gp + 16 * eb);
            const f32x4 gn = *(const f32x4*)(gain + 16 * eb + 4 * quadf);
            u32x2 w; w.x = cvtpk(O[eb][0] * r * gn.x * bflo(gw.x), O[eb][1] * r * gn.y * bfhi(gw.x));
            w.y = cvtpk(O[eb][2] * r * gn.z * bflo(gw.y), O[eb][3] * r * gn.w * bfhi(gw.y));
            *(u32x2*)(op + 16 * eb) = w;
        }
    }
}

__device__ __forceinline__ void p0_transpose_item(const float* W, int K, int N, bf16_t* WT, const float* kscale, LAS float* scr, int item, int lane) {
    const int nblk = N / 32, kb = item / nblk, nb = item % nblk, k0 = 64 * kb, n0 = 32 * nb;
    const int n4 = (lane & 7) * 4, kr = lane >> 3;
    f32x4 v[8];
#pragma unroll
    for (int i = 0; i < 8; ++i) v[i] = __builtin_nontemporal_load((const f32x4*)(W + (size_t)(k0 + kr + 8 * i) * N + n0 + n4));
#pragma unroll
    for (int i = 0; i < 8; ++i) { const int kk = kr + 8 * i; const float sc = kscale ? kscale[k0 + kk] : 1.0f; LAS float* d = scr + kk * 33 + n4;
        d[0] = v[i].x * sc; d[1] = v[i].y * sc; d[2] = v[i].z * sc; d[3] = v[i].w * sc; }
    asm volatile("s_waitcnt lgkmcnt(0)" ::: "memory");
    const int c = lane & 7;
#pragma unroll
    for (int j = 0; j < 4; ++j) { const int n = (lane >> 3) + 8 * j; const LAS float* sp = scr + (8 * c) * 33 + n;
        u32x4 o; o.x = cvtpk(sp[0 * 33], sp[1 * 33]); o.y = cvtpk(sp[2 * 33], sp[3 * 33]); o.z = cvtpk(sp[4 * 33], sp[5 * 33]); o.w = cvtpk(sp[6 * 33], sp[7 * 33]);
        *(u32x4*)(WT + (size_t)(n0 + n) * K + k0 + 8 * c) = o; }
    asm volatile("s_waitcnt lgkmcnt(0)" ::: "memory");
}

#define XB_TMO      128
#define XB_XCNT(j)  (256  + 64 * (j))
#define XB_XSUB(j)  (1280 + 64 * (j))
#define XB_XGEN(j)  (2304 + 64 * (j))
#define XB_TOP      3328
#define XB_TOPGEN   3392
#define XCD_BAR_WORDS 3456
#define XB_SPIN_CAP (1u << 18)
__device__ __forceinline__ unsigned xb_ld(unsigned* p)              { return __hip_atomic_load(p, __ATOMIC_RELAXED, __HIP_MEMORY_SCOPE_AGENT); }
__device__ __forceinline__ unsigned xb_add(unsigned* p, unsigned v) { return __hip_atomic_fetch_add(p, v, __ATOMIC_RELAXED, __HIP_MEMORY_SCOPE_AGENT); }
__device__ __forceinline__ unsigned xb_xcc_id() { return (unsigned)__builtin_amdgcn_s_getreg((3 << 11) | 20) & 0xFu; }
#define XB_SPIN(cond, bar) do { unsigned _sp = 0; while (cond) { __builtin_amdgcn_s_sleep(1); \
    if ((++_sp & 255u) == 0u) { if (xb_ld(&(bar)[XB_TMO])) break; if (_sp > XB_SPIN_CAP) { atomicAdd(&(bar)[XB_TMO], 1u); break; } } } } while (0)
struct XcdBarrier { unsigned* bar; unsigned x; volatile LAS unsigned* st; int wid; };
__device__ __forceinline__ XcdBarrier xcd_barrier_post(unsigned* bar, volatile LAS unsigned* st) {
    XcdBarrier b; b.bar = bar; b.x = xb_xcc_id(); b.st = st; b.wid = 0;
    if (threadIdx.x == 0) (void)xb_add(&bar[XB_XCNT(b.x)], 1u);
    return b;
}
__device__ __forceinline__ void xcd_barrier_complete(unsigned* bar, unsigned x, unsigned& nloc, unsigned& nx) {
    const unsigned G = gridDim.x * gridDim.y * gridDim.z;
    unsigned sum, cnt, mine, sp = 0u;
    for (;;) {
        sum = 0u; cnt = 0u; mine = 0u;
#pragma unroll
        for (unsigned j = 0; j < 16; ++j) { const unsigned c = xb_ld(&bar[XB_XCNT(j)]); sum += c; cnt += (c > 0u) ? 1u : 0u; mine = (j == x) ? c : mine; }
        if (sum == G) break;
        __builtin_amdgcn_s_sleep(1);
        if ((++sp & 255u) == 0u) { if (xb_ld(&bar[XB_TMO])) break; if (sp > XB_SPIN_CAP) { atomicAdd(&bar[XB_TMO], 1u); break; } }
    }
    nloc = mine > 0u ? mine : 1u; nx = cnt > 0u ? cnt : 1u;
}
__device__ __forceinline__ void xcd_barrier(const XcdBarrier& b) {
    asm volatile("s_waitcnt vmcnt(0)" ::: "memory");
    __syncthreads();
    if (b.wid == 0 && lane_id() == 0) {
        unsigned* bar = b.bar;
        __builtin_amdgcn_s_waitcnt(0);
        unsigned nloc = b.st[0], nx = b.st[1];
        if (nloc == 0u) { xcd_barrier_complete(bar, b.x, nloc, nx); b.st[0] = nloc; b.st[1] = nx; }
        const unsigned old = xb_add(&bar[XB_XSUB(b.x)], 1u);
        const unsigned gen = old / nloc;
        if (old + 1u == (gen + 1u) * nloc) {
            __builtin_amdgcn_fence(__ATOMIC_RELEASE, "agent");
            asm volatile("s_waitcnt vmcnt(0)" ::: "memory");
            const unsigned og = xb_add(&bar[XB_TOP], 1u);
            const unsigned tg = og / nx;
            if (og + 1u == (tg + 1u) * nx) xb_add(&bar[XB_TOPGEN], 1u);
            else XB_SPIN(xb_ld(&bar[XB_TOPGEN]) == tg, bar);
            __builtin_amdgcn_fence(__ATOMIC_ACQUIRE, "agent");
            xb_add(&bar[XB_XGEN(b.x)], 1u);
            asm volatile("s_waitcnt vmcnt(0)" ::: "memory");
        } else {
            XB_SPIN(xb_ld(&bar[XB_XGEN(b.x)]) == gen, bar);
            __builtin_amdgcn_fence(__ATOMIC_ACQUIRE, "agent");
            asm volatile("s_waitcnt vmcnt(0)" ::: "memory");
        }
    }
    __syncthreads();
}

#ifndef N_LAUNCHES
#define N_LAUNCHES 1
#endif
#ifndef REP0
#define REP0 1
#endif
#ifndef REP1
#define REP1 1
#endif
#ifndef REP3
#define REP3 1
#endif
#ifndef REP4
#define REP4 1
#endif
#ifndef REP2
#define REP2 1
#endif
__device__ __forceinline__ const float* ld_uptr(const unsigned char* tblbase, int k) {
    const unsigned long long v = *(const GAS unsigned long long*)(tblbase + 8 * k);
    const unsigned lo = __builtin_amdgcn_readfirstlane((unsigned)v), hi = __builtin_amdgcn_readfirstlane((unsigned)(v >> 32));
    return (const float*)(((unsigned long long)hi << 32) | lo);
}
struct Args { const float* in[16]; float* out; unsigned char* ws; int ph_lo, ph_hi; };

__global__ void __launch_bounds__(NWAVES * 64, 2) fwd(Args args) {
    extern __shared__ __attribute__((aligned(16))) unsigned char lds_raw[];
    LAS unsigned char* lds = (LAS unsigned char*)lds_raw;
    const int wid = __builtin_amdgcn_readfirstlane((int)threadIdx.x >> 6);
    const int G = gridDim.x, bx = blockIdx.x;
    const int vcu = (G % 8 == 0) ? (bx % 8) * (G / 8) + bx / 8 : bx;
    unsigned char* ws = args.ws;
    const float* x = args.in[0]; const float* p = args.in[1]; const float* attn_norm = args.in[2]; const float* w_in = args.in[3];
    const float* ret_gn = args.in[4]; const float* diff_qn = args.in[5]; const float* diff_kn = args.in[6];
    const float* lq1 = args.in[7]; const float* lk1 = args.in[8]; const float* lq2 = args.in[9]; const float* lk2 = args.in[10];
    const float* subln = args.in[11]; const float* w_out = args.in[12]; const float* ple_norm = args.in[13];
    const float* w_gate = args.in[14]; const float* w_proj = args.in[15];
    float* out = args.out;
    float* rowss = (float*)(ws + WS_ROWSS); float* tab = (float*)(ws + WS_TAB);
    bf16_t* WinT = (bf16_t*)(ws + WS_WIN); bf16_t* WoutT = (bf16_t*)(ws + WS_WOUT); bf16_t* WgT = (bf16_t*)(ws + WS_WG); bf16_t* WpT = (bf16_t*)(ws + WS_WP);
    bf16_t* U = (bf16_t*)(ws + WS_U); bf16_t* MIX = (bf16_t*)(ws + WS_MIX); bf16_t* PB = (bf16_t*)(ws + WS_PB);
    bf16_t* Z = (bf16_t*)(ws + WS_Z); bf16_t* HB = (bf16_t*)(ws + WS_HB); bf16_t* PP = (bf16_t*)(ws + WS_PP);
    const int lo = args.ph_lo, hi = args.ph_hi;
    volatile LAS unsigned* MISC = (volatile LAS unsigned*)(lds + LDS_BYTES - 64);
    if (threadIdx.x < 16) MISC[threadIdx.x] = 0u;
    __syncthreads();
    XcdBarrier xbar; xbar.bar = (unsigned*)(ws + WS_BAR); xbar.x = 0; xbar.st = MISC; xbar.wid = wid;
    if (hi - lo > 1) { xbar = xcd_barrier_post((unsigned*)(ws + WS_BAR), MISC); xbar.wid = wid; }
#define IN(k) (lo <= (k) && (k) < hi)
#define SEAM(k) do { if (IN(k) && IN((k) + 1)) xcd_barrier(xbar); } while (0)

    for (int rep0 = 0; rep0 < REP0; ++rep0)
    if (IN(0)) {
        int lane = lane_id(); asm volatile("" : "+v"(lane)); const int tid = wid * 64 + lane;
        LAS float* scr = (LAS float*)(lds + wid * 16384);
        const int gw = vcu * NWAVES + wid, NGW = G * NWAVES;
        constexpr int I_IN = (DM / 64) * (DIN / 32), I_OUT = (DM / 64) * (DM / 32), I_G = I_OUT, I_P = (PLE / 64) * (DM / 32);
        constexpr int NITEMS = I_IN + I_P;
        for (int it = gw; it < NITEMS; it += NGW) {
            int r = it;
            if (r < I_IN) { p0_transpose_item(w_in, DM, DIN, WinT, nullptr, scr, r, lane); continue; } r -= I_IN;
            p0_transpose_item(w_proj, PLE, DM, WpT, nullptr, scr, r, lane);
        }
        for (int m = gw; m < M; m += NGW) {
            const f32x4* xr = (const f32x4*)(x + (size_t)m * DM) + lane;
            f32x4 v[8]; float s = 0.f;
#pragma unroll
            for (int j = 0; j < 8; ++j) { v[j] = __builtin_nontemporal_load(xr + 64 * j); s += (v[j].x * v[j].x + v[j].y * v[j].y) + (v[j].z * v[j].z + v[j].w * v[j].w); }
            const float rs = rsqrtf(wave_sum(s) * (1.0f / DM) + EPS);
            u32x2* o8 = (u32x2*)(U + (size_t)m * DM) + lane;
#pragma unroll
            for (int j = 0; j < 8; ++j) { const f32x4 g = ((const f32x4*)attn_norm)[lane + 64 * j]; u32x2 w; w.x = cvtpk(v[j].x * rs * g.x, v[j].y * rs * g.y); w.y = cvtpk(v[j].z * rs * g.z, v[j].w * rs * g.w); o8[64 * j] = w; }
        }
        const int gt = vcu * (NWAVES * 64) + tid, NGT = G * NWAVES * 64;
        for (int i = gt; i < M * PLE / 8; i += NGT) {
            const f32x4 a = __builtin_nontemporal_load((const f32x4*)p + 2 * i), b2 = __builtin_nontemporal_load((const f32x4*)p + 2 * i + 1);
            u32x4 w; w.x = cvtpk(a.x, a.y); w.y = cvtpk(a.z, a.w); w.z = cvtpk(b2.x, b2.y); w.w = cvtpk(b2.z, b2.w);
            ((u32x4*)PB)[i] = w;
        }
        for (int i = gt; i < SEQ * 32; i += NGT) {
            const int pos = i >> 5, k = i & 31;
            double f = 1.0; for (int q = 0; q < k; ++q) f *= 0.7498942093324559;
            const double rev = (double)pos * f * 0.15915494309189535;
            const float fr = (float)(rev - floor(rev));
            tab[2 * i] = __builtin_amdgcn_cosf(fr); tab[2 * i + 1] = __builtin_amdgcn_sinf(fr);
        }
        for (int i = gt; i < M; i += NGT) rowss[i] = 0.f;
        if (bx == 0 && tid < 17) ((const float**)(ws + WS_PTRS))[tid] = (tid < 16) ? args.in[tid] : (const float*)args.out;
    }
    SEAM(0);

    for (int rep1 = 0; rep1 < REP1; ++rep1)
    if (IN(1)) {
        const bool split = (G == 256); const int GG = split ? 224 : G;
        { pg8::Gemm g{U, WinT, M, DIN, DM}; pg8::StaticOrder S; S.init(M, DIN, GG, (bx < GG) ? bx : -1);
          pg8::EpiZ E{Z, tab, diff_qn, diff_kn};
          pg8::gemm_phase<pg8::EpiZ, true>(lds, g, S, E, wid); }
        { pg8::Gemm g{PB, WpT, M, DM, PLE}; pg8::StaticOrder S;
          if (split) S.init(M, DM, 32, bx - 224); else S.init(M, DM, G, bx);
          pg8::EpiBf E{PP, DM};
          pg8::gemm_phase<pg8::EpiBf, true>(lds, g, S, E, wid); }
        {
            int l3 = lane_id(); asm volatile("" : "+v"(l3));
            LAS float* scr = (LAS float*)(lds + wid * 16384);
            constexpr int I_OUT = (DM / 64) * (DM / 32);
            const int first = split ? 224 : 0, nw = (G - first) * NWAVES;
            if (bx >= first)
                for (int it = (bx - first) * NWAVES + wid; it < 2 * I_OUT; it += nw) {
                    if (it < I_OUT) p0_transpose_item(w_out, DM, DM, WoutT, nullptr, scr, it, l3);
                    else p0_transpose_item(w_gate, DM, DM, WgT, ple_norm, scr, it - I_OUT, l3);
                }
        }
    }
    SEAM(1);

    for (int rep2 = 0; rep2 < REP2; ++rep2)
    if (IN(2)) {
        unsigned char* wsp = ws; asm volatile("" : "+s"(wsp)); const unsigned char* tbl = wsp + WS_PTRS;
        const float* ret_gn = ld_uptr(tbl, 4); const float* diff_qn = ld_uptr(tbl, 5); const float* diff_kn = ld_uptr(tbl, 6); const float* lq1 = ld_uptr(tbl, 7); const float* lk1 = ld_uptr(tbl, 8);
        const float* lq2 = ld_uptr(tbl, 9); const float* lk2 = ld_uptr(tbl, 10); const float* subln = ld_uptr(tbl, 11);
        bf16_t* Z = (bf16_t*)(wsp + WS_Z); bf16_t* MIX = (bf16_t*)(wsp + WS_MIX);
        int lane2 = lane_id(); asm volatile("" : "+v"(lane2));
        const float d1 = wave_sum(lq1[lane2] * lk1[lane2]), d2 = wave_sum(lq2[lane2] * lk2[lane2]);
        float lam; { float lv = __expf(d1) - __expf(d2) + 0.2f; asm volatile("" : "+v"(lv)); lam = __uint_as_float(__builtin_amdgcn_readfirstlane(__float_as_uint(lv))); }
        const float mq = wave_max(fabsf(diff_qn[lane2])), mk = wave_max(fabsf(diff_kn[lane2]));
        float shift; { float sv = 11.541560327111707f * mq * mk; asm volatile("" : "+v"(sv)); shift = __uint_as_float(__builtin_amdgcn_readfirstlane(__float_as_uint(sv))); }
        for (int pi = vcu; pi < 256; pi += G) {
            const int bh = pi >> 3, tp = pi & 7, b = bh >> 3, h = bh & 7;
            attn_item<true>(lds, Z, MIX, b, h, 15 - tp, lam, shift, subln, 0, wid, 0);
            ret_pair(lds, Z, MIX, b, h, 15 - tp, tp, ret_gn + 128 * h, wid);
            attn_item<true>(lds, Z, MIX, b, h, tp, lam, shift, subln, 0, wid, 0);
        }
        __syncthreads();
    }
    SEAM(2);

    if (IN(3)) {
        unsigned char* wsp = ws; asm volatile("" : "+s"(wsp)); const unsigned char* tbl = wsp + WS_PTRS;
        const float* x = ld_uptr(tbl, 0); float* out = (float*)ld_uptr(tbl, 16);
        bf16_t* MIX = (bf16_t*)(wsp + WS_MIX); bf16_t* WoutT = (bf16_t*)(wsp + WS_WOUT); bf16_t* HB = (bf16_t*)(wsp + WS_HB); float* rowss = (float*)(wsp + WS_ROWSS);
        pg8::Gemm g{MIX, WoutT, M, DM, DM}; pg8::StaticOrder S; S.init(M, DM, G, bx);
#if REP3 > 1
        { pg8::EpiH E0{x, out, HB, rowss + 8192}; pg8::gemm_phase<pg8::EpiH, true>(lds, g, S, E0, wid); }
#endif
        pg8::EpiH E{x, out, HB, rowss};
        pg8::gemm_phase<pg8::EpiH, true>(lds, g, S, E, wid);
    }
    SEAM(3);

    if (IN(4)) {
        unsigned char* wsp = ws; asm volatile("" : "+s"(wsp)); const unsigned char* tbl = wsp + WS_PTRS;
        float* out = (float*)ld_uptr(tbl, 16);
        bf16_t* HB = (bf16_t*)(wsp + WS_HB); bf16_t* WgT = (bf16_t*)(wsp + WS_WG); bf16_t* PP = (bf16_t*)(wsp + WS_PP); float* rowss = (float*)(wsp + WS_ROWSS);
        pg8::Gemm g{HB, WgT, M, DM, DM}; pg8::StaticOrder S; S.init(M, DM, G, bx);
#if REP4 > 1
        { pg8::EpiOut E0{HB, (float*)(ws + WS_Z + 40 * MiB), PP, rowss}; pg8::gemm_phase<pg8::EpiOut, true>(lds, g, S, E0, wid); }
#endif
        pg8::EpiOut E{HB, out, PP, rowss};
        pg8::gemm_phase<pg8::EpiOut, true>(lds, g, S, E, wid);
    }
#undef IN
#undef SEAM
}

#ifndef N_LAUNCHES_DUMMY
#define N_LAUNCHES 1
#endif

extern "C" void kernel_launch(void* const* d_in, const int* in_sizes, int n_in, void* d_out, int out_size, void* d_ws, size_t ws_size, hipStream_t stream) {
    static int grid = 0;
    if (grid == 0) {
        if (n_in != 16 || out_size != M * DM || ws_size < WS_END) { fprintf(stderr, "kernel_launch: unexpected problem (n_in %d out %d ws %zu)\n", n_in, out_size, ws_size); grid = -1; return; }
        int dev = 0, cus = 0, per_cu = 0;
        if (hipGetDevice(&dev) != hipSuccess || hipDeviceGetAttribute(&cus, hipDeviceAttributeMultiprocessorCount, dev) != hipSuccess) { grid = -1; return; }
        if (hipFuncSetAttribute((const void*)fwd, hipFuncAttributeMaxDynamicSharedMemorySize, LDS_BYTES) != hipSuccess) { fprintf(stderr, "kernel_launch: hipFuncSetAttribute failed\n"); grid = -1; return; }
        if (hipOccupancyMaxActiveBlocksPerMultiprocessor(&per_cu, (const void*)fwd, NWAVES * 64, LDS_BYTES) != hipSuccess || per_cu < 1) { fprintf(stderr, "kernel_launch: occupancy query says %d\n", per_cu); grid = -1; return; }
        grid = cus * per_cu;
    }
    if (grid < 0) return;
    if (hipMemsetAsync((char*)d_ws + WS_BAR, 0, XCD_BAR_WORDS * 4, stream) != hipSuccess) { fprintf(stderr, "kernel_launch: memset failed\n"); return; }
    Args a{};
    for (int i = 0; i < 16; ++i) a.in[i] = (const float*)d_in[i];
    a.out = (float*)d_out; a.ws = (unsigned char*)d_ws;
#if N_LAUNCHES == 1
    a.ph_lo = 0; a.ph_hi = 5;
    void* kargs[] = {&a};
    hipError_t e = hipLaunchCooperativeKernel((const void*)fwd, dim3(grid), dim3(NWAVES * 64), kargs, LDS_BYTES, stream);
    if (e != hipSuccess) fprintf(stderr, "cooperative launch failed: %s (grid %d)\n", hipGetErrorString(e), grid);
#else
    for (int ph = 0; ph < 5; ++ph) { a.ph_lo = ph; a.ph_hi = ph + 1; hipLaunchKernelGGL(fwd, dim3(grid), dim3(NWAVES * 64), LDS_BYTES, stream, a); }
#endif
}
```
